# Optimizing an MI355X kernel written in HIP

```python
import jax, jax.numpy as jnp
from jax import lax
import numpy as np

D_MODEL = 1024
BATCH = 4
SEQ = 8192
DEPTH = 2

GRID_W = 64
WIN_ROWS = 8
WIN_COLS = 16
N_ATTN_HEADS = 8
HEAD_DIM = 64
D_ATTN = N_ATTN_HEADS * HEAD_DIM
N_FOURIER_GROUPS = 4
FOURIER_GROUP = 128
D_FOURIER = N_FOURIER_GROUPS * FOURIER_GROUP
D_MIX = D_ATTN + D_FOURIER
D_IN = 3 * D_ATTN + D_FOURIER
D_FF = 2816
ALPHA = (2.0 * DEPTH) ** 0.25
BETA = (8.0 * DEPTH) ** -0.25
LN_EPS = 1e-5
RMS_EPS = 1e-6
NEG_INF = -1e30

kernel_name = "hybrid_natten_fnet_macaron_deepnorm"


def layer_norm(x, g, b):
    xf = x.astype(jnp.float32)
    mu = jnp.mean(xf, axis=-1, keepdims=True)
    xc = xf - mu
    var = jnp.mean(xc * xc, axis=-1, keepdims=True)
    y = xc * lax.rsqrt(var + LN_EPS) * g.astype(jnp.float32) + b.astype(jnp.float32)
    return y.astype(x.dtype)


def rms_norm(x, g):
    xf = x.astype(jnp.float32)
    y = xf * lax.rsqrt(jnp.mean(xf * xf, axis=-1, keepdims=True) + RMS_EPS)
    return y * g.astype(jnp.float32)


def swiglu(x, w_gate, w_up, w_down):
    return (jax.nn.silu(x @ w_gate) * (x @ w_up)) @ w_down


def neighbourhood_attention(q, k, v, rpb):
    B, S, H, Dh = q.shape
    R = S // GRID_W
    KH = min(WIN_ROWS, R)

    def to_grid(t):
        return t.reshape(B, R, GRID_W, H, Dh).transpose(0, 3, 1, 2, 4).astype(jnp.float32)

    rows = jnp.arange(R)
    r0 = jnp.clip(rows - KH // 2, 0, R - KH)
    row_idx = r0[:, None] + jnp.arange(KH)[None, :]
    dr = row_idx - rows[:, None]

    cols = jnp.arange(GRID_W)
    c0 = jnp.clip(cols - WIN_COLS // 2, 0, GRID_W - WIN_COLS)
    dc = cols[None, :] - cols[:, None]
    in_win = (cols[None, :] >= c0[:, None]) & (cols[None, :] < c0[:, None] + WIN_COLS)
    dc_idx = jnp.clip(dc, -(WIN_COLS - 1), WIN_COLS - 1) + (WIN_COLS - 1)
    dr_idx = dr + (WIN_ROWS - 1)

    bias = rpb.astype(jnp.float32)[:, dr_idx[:, None, :, None], dc_idx[None, :, None, :]]
    mask = jnp.where(in_win, 0.0, NEG_INF).astype(jnp.float32)[None, None, :, None, :]
    bias = bias + mask

    qg = to_grid(q) * (Dh ** -0.5)
    kg = to_grid(k)[:, :, row_idx]
    vg = to_grid(v)[:, :, row_idx]

    scores = jnp.einsum('bhrqd,bhrnkd->bhrqnk', qg, kg) + bias[None]
    p = jax.nn.softmax(scores.reshape(B, H, R, GRID_W, KH * GRID_W), axis=-1)
    p = p.reshape(scores.shape)
    o = jnp.einsum('bhrqnk,bhrnkd->bhrqd', p, vg)
    return o.transpose(0, 2, 3, 1, 4).reshape(B, S, H * Dh)


def fourier_mix(u):
    B, S, _ = u.shape
    ug = u.reshape(B, S, N_FOURIER_GROUPS, FOURIER_GROUP).astype(jnp.float32)
    y = jnp.fft.fft2(ug, axes=(1, 3), norm="ortho").real
    return y.reshape(B, S, D_FOURIER)


def setup_inputs(seed: int = 0) -> dict:
    key = jax.random.key(seed)
    ks = jax.random.split(key, 24)
    f32 = jnp.float32

    def nrm(k, shape, scale):
        return jax.random.normal(k, shape, f32) * scale

    def gain(k, shape):
        return 1.0 + 0.05 * jax.random.normal(k, shape, f32)

    def bias(k, shape):
        return 0.02 * jax.random.normal(k, shape, f32)

    L, D, F = DEPTH, D_MODEL, D_FF
    x = jax.random.normal(ks[0], (BATCH, SEQ, D), f32)

    w_in = nrm(ks[7], (L, D, D_IN), D ** -0.5)
    col_scale = jnp.concatenate([jnp.ones((2 * D_ATTN,), f32), jnp.full((D_ATTN,), BETA, f32),
                                 jnp.ones((D_FOURIER,), f32)])
    w_in = w_in * col_scale

    return {
        "x": x,
        "ffn1_w_gate": nrm(ks[1], (L, D, F), D ** -0.5),
        "ffn1_w_up": nrm(ks[2], (L, D, F), D ** -0.5),
        "ffn1_w_down": nrm(ks[3], (L, F, D), BETA * F ** -0.5),
        "ln1_g": gain(ks[4], (L, D)),
        "ln1_b": bias(ks[5], (L, D)),
        "w_in": w_in,
        "rpb": nrm(ks[8], (L, N_ATTN_HEADS, 2 * WIN_ROWS - 1, 2 * WIN_COLS - 1), 0.1),
        "g_attn": gain(ks[9], (L, D_ATTN)),
        "g_fourier": gain(ks[10], (L, D_FOURIER)),
        "w_out": nrm(ks[11], (L, D_MIX, D), BETA * D_MIX ** -0.5),
        "ln2_g": gain(ks[12], (L, D)),
        "ln2_b": bias(ks[13], (L, D)),
        "ffn2_w_gate": nrm(ks[14], (L, D, F), D ** -0.5),
        "ffn2_w_up": nrm(ks[15], (L, D, F), D ** -0.5),
        "ffn2_w_down": nrm(ks[16], (L, F, D), BETA * F ** -0.5),
        "ln3_g": gain(ks[17], (L, D)),
        "ln3_b": bias(ks[18], (L, D)),
    }


def reference(x, ffn1_w_gate, ffn1_w_up, ffn1_w_down, ln1_g, ln1_b, w_in, rpb,
              g_attn, g_fourier, w_out, ln2_g, ln2_b, ffn2_w_gate, ffn2_w_up,
              ffn2_w_down, ln3_g, ln3_b):
    B, S, D = x.shape
    for l in range(DEPTH):
        x = layer_norm(ALPHA * x + 0.5 * swiglu(x, ffn1_w_gate[l], ffn1_w_up[l], ffn1_w_down[l]),
                       ln1_g[l], ln1_b[l])

        proj = x @ w_in[l]
        q = proj[..., :D_ATTN].reshape(B, S, N_ATTN_HEADS, HEAD_DIM)
        k = proj[..., D_ATTN:2 * D_ATTN].reshape(B, S, N_ATTN_HEADS, HEAD_DIM)
        v = proj[..., 2 * D_ATTN:3 * D_ATTN].reshape(B, S, N_ATTN_HEADS, HEAD_DIM)
        u = proj[..., 3 * D_ATTN:]

        attn = neighbourhood_attention(q, k, v, rpb[l])
        four = fourier_mix(u)
        merged = jnp.concatenate([rms_norm(attn, g_attn[l]), rms_norm(four, g_fourier[l])],
                                 axis=-1).astype(x.dtype)
        x = layer_norm(ALPHA * x + merged @ w_out[l], ln2_g[l], ln2_b[l])

        x = layer_norm(ALPHA * x + 0.5 * swiglu(x, ffn2_w_gate[l], ffn2_w_up[l], ffn2_w_down[l]),
                       ln3_g[l], ln3_b[l])
    return x
```

```cpp
#include <hip/hip_cooperative_groups.h>
#include <cstdio>
#include <cstdint>
namespace pg8 {
#define PG8_LAS __attribute__((address_space(3)))
typedef unsigned short bf16_t;
typedef short bf16x8 __attribute__((ext_vector_type(8)));
typedef float f32x4 __attribute__((ext_vector_type(4)));
typedef unsigned u32x4 __attribute__((ext_vector_type(4)));
constexpr int BM = 256, BK = 64, HALF = 128, HTB = HALF * BK * 2  , STAGE_BYTES = 8 * HTB, NXCD = 8, WGM = 8;

__host__ __device__ __forceinline__ int lds_byte(int r, int c) { const int st = (r >> 4) * 2 + (c >> 5), rr = r & 15, cc = c & 31, ob = rr * 64 + cc * 2; return st * 1024 + (ob ^ (((ob >> 9) & 1) << 5)); }
__host__ __device__ __forceinline__ void stage_rc(int b, int& R, int& C) { const int st = b / 1024, sb = b % 1024, swz = sb ^ (((sb >> 9) & 1) << 5); R = (st >> 1) * 16 + swz / 64; C = (st & 1) * 32 + (swz % 64) / 2; }
__host__ __device__ __forceinline__ int perm32(int rho) { const int n = rho >> 4, i = rho & 15; return 8 * (i >> 2) + 4 * n + (i & 3); }

struct Unit { int pm, pn; };
struct Gemm { const bf16_t* A; const bf16_t* Bt; int M, N, K; };

struct StaticOrder {
    int nM, nN, nwg, G, c;
    __host__ __device__ void init(int M, int N, int G_, int c_) { nM = M / BM; nN = N / BM; nwg = nM * nN; G = G_; c = c_; }
    __host__ __device__ bool next(int i, Unit& u) const {
        const long L = (long)i * G + c; if (L >= nwg) return false;
        int wgid = (int)L; { const int q = nwg / NXCD, r = nwg % NXCD, xcd = wgid % NXCD, off = wgid / NXCD; wgid = (xcd < r ? xcd * (q + 1) : r * (q + 1) + (xcd - r) * q) + off; }
        const int nig = WGM * nN, gid = wgid / nig, fm = gid * WGM, gsz = (nM - fm) < WGM ? (nM - fm) : WGM;
        u.pm = fm + ((wgid % nig) % gsz); u.pn = (wgid % nig) / gsz; return true;
    }
    __device__ __forceinline__ void a_ready(const Unit&) const {}
    __device__ __forceinline__ void done(const Unit&) const {}
};
__device__ __forceinline__ unsigned cvt_pk_bf16(float lo, float hi) { unsigned r; asm volatile("v_cvt_pk_bf16_f32 %0, %1, %2" : "=v"(r) : "v"(lo), "v"(hi)); return r; }
typedef float f32x2 __attribute__((ext_vector_type(2)));
template <class Epi, class Sched, bool STAMP = false>
__device__ __forceinline__ void gemm_phase(PG8_LAS unsigned char* lds, const Gemm g, const Sched& S, const Epi& E, unsigned long long* stamps) {
    int tid_ = threadIdx.x; asm volatile("" : "+v"(tid_));
    const int tid = tid_, wid = __builtin_amdgcn_readfirstlane(tid >> 6), lane = tid & 63, wr = wid >> 2, wc = wid & 3, fr = lane & 15, fq = lane >> 4;
    const int K = g.K, nt = K / BK;
    int ts_lo = 0, ts_hi = 0, nts = 0; const unsigned long long rt_entry = STAMP ? (unsigned long long)wall_clock64() : 0ull;
#define PG8_STAMP() do { if (STAMP && wid == 0 && nts < 64) { const unsigned long long _c = (unsigned long long)clock64(); \
        ts_lo = (lane == nts) ? (int)(unsigned)_c : ts_lo; ts_hi = (lane == nts) ? (int)(unsigned)(_c >> 32) : ts_hi; ++nts; } } while (0)
    PG8_STAMP();
    unsigned voffA[2], voffB[2];
#pragma unroll
    for (int i = 0; i < 2; ++i) { int R, C; stage_rc(tid * 16 + i * 8192, R, C); const int Rb = Epi::PERM ? ((R & ~31) + perm32(R & 31)) : R;
        voffA[i] = (unsigned)(R * K + C) * 2u; voffB[i] = (unsigned)(Rb * K + C) * 2u; }
    const size_t kstep = (size_t)(BK * 2);
    const size_t hstep = (size_t)HALF * K * 2;
    const size_t tstep = 2 * hstep;
    const unsigned ldsw = (unsigned)wid * 1024u;
    const int aoff = lds_byte(wr * 64 + fr, fq * 8), boff = lds_byte(wc * 32 + fr, fq * 8);
#define PG8_SA(b, h) (((b) * 2 + (h)) * HTB)
#define PG8_SB(b, h) ((4 + (b) * 2 + (h)) * HTB)
#define PG8_STAGE(bufoff, gbase, voff) do { _Pragma("unroll") for (int _i = 0; _i < 2; ++_i) \
        __builtin_amdgcn_global_load_lds((const unsigned*)((const char*)(gbase) + (voff)[_i]), (PG8_LAS unsigned*)(lds + (bufoff) + ldsw + _i * 8192), 16, 0, 0); } while (0)
#define PG8_LDA(dst, b, h) do { _Pragma("unroll") for (int m = 0; m < 4; ++m) _Pragma("unroll") for (int k = 0; k < 2; ++k) dst[m][k] = *(const PG8_LAS bf16x8*)(lds + PG8_SA(b, h) + aoff + m * 2048 + k * 1024); } while (0)
#define PG8_LDB(dst, b, h) do { _Pragma("unroll") for (int n = 0; n < 2; ++n) _Pragma("unroll") for (int k = 0; k < 2; ++k) dst[n][k] = *(const PG8_LAS bf16x8*)(lds + PG8_SB(b, h) + boff + n * 2048 + k * 1024); } while (0)
#define PG8_MMA(ai, bj, At, Bt) do { __builtin_amdgcn_s_setprio(1); _Pragma("unroll") for (int m = 0; m < 4; ++m) _Pragma("unroll") for (int n = 0; n < 2; ++n) _Pragma("unroll") for (int k = 0; k < 2; ++k) \
        acc[ai][bj][m][n] = __builtin_amdgcn_mfma_f32_16x16x32_bf16(Bt[n][k], At[m][k], acc[ai][bj][m][n], 0, 0, 0); __builtin_amdgcn_s_setprio(0); } while (0)
#define PG8_WAIT_V(n) asm volatile("s_waitcnt vmcnt(" #n ")" ::: "memory")
#define PG8_WAIT_L(n) asm volatile("s_waitcnt lgkmcnt(" #n ")" ::: "memory")
#define PG8_BAR __builtin_amdgcn_s_barrier()
#define PG8_SCHED __builtin_amdgcn_sched_barrier(0)
    Unit cur, nxt; int ui = 0;
    if (!S.next(0, cur)) return;
    f32x4 acc[2][2][4][2];
#pragma unroll
    for (int a = 0; a < 2; ++a)
#pragma unroll
        for (int b = 0; b < 2; ++b)
#pragma unroll
            for (int m = 0; m < 4; ++m)
#pragma unroll
                for (int n = 0; n < 2; ++n) acc[a][b][m][n] = (f32x4){0.f, 0.f, 0.f, 0.f};
    bf16x8 At[4][2], B0[2][2], B1[2][2];
    const char* cA = (const char*)g.A + (size_t)cur.pm * tstep; const char* cB = (const char*)g.Bt + (size_t)cur.pn * tstep;
    S.a_ready(cur);
    PG8_STAGE(PG8_SB(0, 0), cB, voffB); PG8_STAGE(PG8_SA(0, 0), cA, voffA); PG8_STAGE(PG8_SB(0, 1), cB + hstep, voffB); PG8_STAGE(PG8_SA(0, 1), cA + hstep, voffA);
    if (wr == 1) PG8_BAR;
    PG8_WAIT_V(4); PG8_BAR;
    PG8_STAGE(PG8_SB(1, 0), cB + kstep, voffB); PG8_STAGE(PG8_SA(1, 0), cA + kstep, voffA); PG8_STAGE(PG8_SB(1, 1), cB + hstep + kstep, voffB);
    PG8_WAIT_V(6); PG8_BAR;
    PG8_STAMP();
    for (;;) {
        const bool has_next = S.next(ui + 1, nxt);
        const char* nA = has_next ? (const char*)g.A + (size_t)nxt.pm * tstep : cA; const char* nB = has_next ? (const char*)g.Bt + (size_t)nxt.pn * tstep : cB;
        for (int t = 0; t < nt; t += 2) {
            const bool last = (t == nt - 2);
            const char* a1 = cA + (size_t)(t + 1) * kstep;
            const char* a2 = last ? nA : cA + (size_t)(t + 2) * kstep; const char* b2 = last ? nB : cB + (size_t)(t + 2) * kstep;
            const char* a3 = a2 + kstep; const char* b3 = b2 + kstep;
            if (last && has_next) S.a_ready(nxt);
            PG8_LDB(B0, 0, 0); PG8_SCHED; PG8_LDA(At, 0, 0); PG8_STAGE(PG8_SA(1, 1), a1 + hstep, voffA);
            PG8_WAIT_L(8); PG8_BAR; PG8_WAIT_L(0); PG8_MMA(0, 0, At, B0); PG8_BAR; PG8_SCHED;
            PG8_LDB(B1, 0, 1); PG8_STAGE(PG8_SB(0, 0), b2, voffB);
            PG8_BAR; PG8_WAIT_L(0); PG8_MMA(0, 1, At, B1); PG8_BAR;
            PG8_LDA(At, 0, 1); PG8_STAGE(PG8_SA(0, 0), a2, voffA);
            PG8_BAR; PG8_WAIT_L(0); PG8_MMA(1, 0, At, B0); PG8_BAR; PG8_SCHED;
            PG8_STAGE(PG8_SB(0, 1), b2 + hstep, voffB);
            PG8_WAIT_V(6); PG8_BAR; PG8_MMA(1, 1, At, B1); PG8_BAR;
            PG8_LDB(B0, 1, 0); PG8_SCHED; PG8_LDA(At, 1, 0); PG8_STAGE(PG8_SA(0, 1), a2 + hstep, voffA);
            PG8_WAIT_L(8); PG8_BAR; PG8_WAIT_L(0); PG8_MMA(0, 0, At, B0); PG8_BAR; PG8_SCHED;
            PG8_LDB(B1, 1, 1); PG8_STAGE(PG8_SB(1, 0), b3, voffB);
            PG8_BAR; PG8_WAIT_L(0); PG8_MMA(0, 1, At, B1); PG8_BAR;
            PG8_LDA(At, 1, 1); PG8_STAGE(PG8_SA(1, 0), a3, voffA);
            PG8_BAR; PG8_WAIT_L(0); PG8_MMA(1, 0, At, B0); PG8_BAR; PG8_SCHED;
            PG8_STAGE(PG8_SB(1, 1), b3 + hstep, voffB);
            PG8_WAIT_V(6); PG8_BAR; PG8_MMA(1, 1, At, B1); PG8_BAR;
        }
        PG8_STAMP();
        if constexpr (!Epi::AFTER_DRAIN) { E(acc, cur, wr, wc, fr, fq); S.done(cur); }
        PG8_STAMP();
        if (!has_next) break;
#pragma unroll
        for (int a = 0; a < 2; ++a)
#pragma unroll
            for (int b = 0; b < 2; ++b)
#pragma unroll
                for (int m = 0; m < 4; ++m)
#pragma unroll
                    for (int n = 0; n < 2; ++n) acc[a][b][m][n] = (f32x4){0.f, 0.f, 0.f, 0.f};
        cur = nxt; cA = nA; cB = nB; ++ui;
    }
    PG8_WAIT_V(0);
    if (wr == 0) PG8_BAR;
    PG8_BAR;
    if constexpr (Epi::AFTER_DRAIN) { E.fused(acc, cur, wr, wc, fr, fq, lds, wid, lane); S.done(cur); }
    PG8_STAMP();
    if (STAMP && wid == 0) { stamps[lane] = lane < nts ? (((unsigned long long)(unsigned)ts_hi << 32) | (unsigned)ts_lo) : 0ull;
        if (lane == 62) stamps[62] = rt_entry; if (lane == 63) stamps[63] = (unsigned long long)wall_clock64(); }
#undef PG8_STAMP
#undef PG8_SA
#undef PG8_SB
#undef PG8_STAGE
#undef PG8_LDA
#undef PG8_LDB
#undef PG8_MMA
#undef PG8_WAIT_V
#undef PG8_WAIT_L
#undef PG8_BAR
#undef PG8_SCHED
}
}

namespace cg = cooperative_groups;
#ifndef MK_STOP
#define MK_STOP 25
#endif

#define LAS __attribute__((address_space(3)))
typedef unsigned short bf16;
typedef float f32x4 __attribute__((ext_vector_type(4)));
typedef float f32x2 __attribute__((ext_vector_type(2)));
typedef short bf16x8 __attribute__((ext_vector_type(8)));
typedef unsigned u32x4 __attribute__((ext_vector_type(4)));
typedef unsigned u32x2 __attribute__((ext_vector_type(2)));

constexpr int NWAVES = 8;
constexpr int MTOK = 32768, DM = 1024, DFF = 2816, SEQ = 8192, NLAYER = 2;
constexpr float ALPHA = 1.41421356237309515f;
constexpr float LN_EPS = 1e-5f, RMS_EPS = 1e-6f;
constexpr int LDS_BYTES = 147456;
constexpr int LDS_MISC = 131072;

constexpr size_t MiB = 1u << 20;
constexpr size_t WS_TAB = 0;
constexpr size_t TAB_F0 = 0, TAB_F1 = 65536, TAB_F2 = 98304, TAB_TW = 163840;
constexpr size_t WS_W = 2 * MiB;
constexpr size_t W_GU = (size_t)5632 * 1024, W_D = (size_t)1024 * 2816, W_IN = (size_t)2048 * 1024, W_OUT = (size_t)1024 * 1024;
constexpr size_t WL_GU1 = 0, WL_D1 = WL_GU1 + W_GU, WL_IN = WL_D1 + W_D, WL_OUT = WL_IN + W_IN, WL_GU2 = WL_OUT + W_OUT, WL_D2 = WL_GU2 + W_GU, WL_END = WL_D2 + W_D;
static_assert(WS_W + 2 * WL_END * 2 <= 82 * MiB, "weights");
constexpr size_t WS_XB = 82 * MiB;
constexpr size_t WS_MG = 146 * MiB;
constexpr size_t WS_H = 210 * MiB;
constexpr size_t WS_Q = 210 * MiB, WS_K = 242 * MiB, WS_VT = 274 * MiB, WS_U = 306 * MiB, WS_Z1 = 338 * MiB, WS_T2 = 210 * MiB;
constexpr size_t WS_END = 402 * MiB;

__device__ __forceinline__ unsigned f2bf(float f) { unsigned u = __builtin_bit_cast(unsigned, f); return (u + 0x7fffu + ((u >> 16) & 1u)) >> 16; }
typedef __bf16 bf16v2 __attribute__((ext_vector_type(2)));
__device__ __forceinline__ unsigned pk2(float lo, float hi) { const f32x2 v = {lo, hi}; const bf16v2 b = __builtin_convertvector(v, bf16v2); return __builtin_bit_cast(unsigned, b); }
#define LDS_WAIT() asm volatile("s_waitcnt lgkmcnt(0)" ::: "memory")

struct EpiSwiGLU {
    static constexpr bool PERM = true, AFTER_DRAIN = false;
    bf16* H;
    __device__ __forceinline__ void operator()(const pg8::f32x4 (&acc)[2][2][4][2], const pg8::Unit& u, int wr, int wc, int fr, int fq) const {
        const int row0 = u.pm * 256 + wr * 64 + fr, col0 = u.pn * 128 + wc * 32 + 8 * fq;
#pragma unroll
        for (int ai = 0; ai < 2; ++ai)
#pragma unroll
            for (int m = 0; m < 4; ++m) {
                bf16* rowp = H + (size_t)(row0 + ai * 128 + m * 16) * DFF + col0;
                float hv[8];
#pragma unroll
                for (int n = 0; n < 2; ++n)
#pragma unroll
                    for (int e = 0; e < 4; ++e) { const float g = acc[ai][0][m][n][e], up = acc[ai][1][m][n][e];
                        const float sg = g * __builtin_amdgcn_rcpf(1.0f + __builtin_amdgcn_exp2f(g * -1.44269504089f)); hv[n * 4 + e] = sg * up; }
                u32x4 w; w.x = pk2(hv[0], hv[1]); w.y = pk2(hv[2], hv[3]); w.z = pk2(hv[4], hv[5]); w.w = pk2(hv[6], hv[7]);
                *(u32x4*)rowp = w;
            }
    }
};
struct EpiResid {
    static constexpr bool PERM = false, AFTER_DRAIN = false;
    const float* src; float* dst; float scale;
    __device__ __forceinline__ void operator()(const pg8::f32x4 (&acc)[2][2][4][2], const pg8::Unit& u, int wr, int wc, int fr, int fq) const {
        const int row0 = u.pm * 256 + wr * 64 + fr, col0 = u.pn * 256 + wc * 32 + 4 * fq;
#pragma unroll
        for (int ai = 0; ai < 2; ++ai)
#pragma unroll
            for (int m = 0; m < 4; ++m) { const size_t off = (size_t)(row0 + ai * 128 + m * 16) * DM + col0;
#pragma unroll
                for (int bj = 0; bj < 2; ++bj)
#pragma unroll
                    for (int n = 0; n < 2; ++n) { const f32x4 s = *(const f32x4*)(src + off + bj * 128 + n * 16); const f32x4 o = s * ALPHA + acc[ai][bj][m][n] * scale; *(f32x4*)(dst + off + bj * 128 + n * 16) = o; }
                asm volatile("" ::: "memory"); }
    }
};
struct EpiProj {
    static constexpr bool PERM = true, AFTER_DRAIN = false;
    bf16* P;
    __device__ __forceinline__ void operator()(const pg8::f32x4 (&acc)[2][2][4][2], const pg8::Unit& u, int wr, int wc, int fr, int fq) const {
        const int t = u.pn >> 1; const int row0 = u.pm * 256 + wr * 64 + fr, cl = (u.pn & 1) * 256 + wc * 32 + 8 * fq;
        if (t != 2) {
            bf16* base = P + (size_t)t * (16u << 20); const float sc = (t == 0) ? 0.125f : 1.0f;
#pragma unroll
            for (int ai = 0; ai < 2; ++ai)
#pragma unroll
                for (int m = 0; m < 4; ++m) { bf16* rowp = base + (size_t)(row0 + ai * 128 + m * 16) * 512 + cl;
#pragma unroll
                    for (int bj = 0; bj < 2; ++bj) { const f32x4 v0 = acc[ai][bj][m][0] * sc, v1 = acc[ai][bj][m][1] * sc;
                        u32x4 w; w.x = pk2(v0[0], v0[1]); w.y = pk2(v0[2], v0[3]); w.z = pk2(v1[0], v1[1]); w.w = pk2(v1[2], v1[3]);
                        *(u32x4*)(rowp + bj * 128) = w; } }
        } else {
            bf16* VT = P + (size_t)(32u << 20);
#pragma unroll
            for (int ai = 0; ai < 2; ++ai)
#pragma unroll
                for (int m = 0; m < 4; ++m) { const int row = row0 + ai * 128 + m * 16; const int b = row >> 13, s = row & 8191;
#pragma unroll
                    for (int bj = 0; bj < 2; ++bj)
#pragma unroll
                        for (int n = 0; n < 2; ++n)
#pragma unroll
                            for (int e = 0; e < 4; ++e) { const int col = cl + bj * 128 + n * 4 + e;
                                VT[((size_t)(b * 512 + col)) * SEQ + s] = (bf16)f2bf(acc[ai][bj][m][n][e]); } }
        }
    }
};

__device__ __forceinline__ float wave_sum(float v) {
#pragma unroll
    for (int o = 1; o < 64; o <<= 1) v += __shfl_xor(v, o);
    return v;
}
__device__ __forceinline__ void p0_transpose_item(const float* W, int K, int N, bf16* WT, int mode, LAS float* scr, int item, int lane) {
    const int nblk = N / 32, kb = item / nblk, nb = item % nblk, k0 = 64 * kb, n0 = 32 * nb;
    const int r0 = (mode == 0) ? n0 : (256 * (n0 >> 7) + (n0 & 127) + (mode == 2 ? 128 : 0));
#pragma unroll 8
    for (int i = 0; i < 32; ++i) { const int kk = 2 * i + (lane >> 5); scr[kk * 33 + (lane & 31)] = W[(size_t)(k0 + kk) * N + n0 + (lane & 31)]; }
    LDS_WAIT(); asm volatile("" ::: "memory");
    const int c = lane & 7;
#pragma unroll
    for (int j = 0; j < 4; ++j) { const int n = (lane >> 3) + 8 * j; const LAS float* s = scr + (8 * c) * 33 + n;
        u32x4 o; o.x = pk2(s[0 * 33], s[1 * 33]); o.y = pk2(s[2 * 33], s[3 * 33]); o.z = pk2(s[4 * 33], s[5 * 33]); o.w = pk2(s[6 * 33], s[7 * 33]);
        *(u32x4*)(WT + (size_t)(r0 + n) * K + k0 + 8 * c) = o; }
    LDS_WAIT(); asm volatile("" ::: "memory");
}
__device__ __forceinline__ void ln_rows(const float* Y, float* XF, bf16* XB, const float* g, const float* b, int gw, int NGW, int lane) {
    for (int m = gw; m < MTOK; m += NGW) {
        const f32x4* xr = (const f32x4*)(Y + (size_t)m * DM) + lane;
        f32x4 v[4]; float s = 0.f;
#pragma unroll
        for (int j = 0; j < 4; ++j) { v[j] = xr[64 * j]; s += (v[j].x + v[j].y) + (v[j].z + v[j].w); }
        const float mean = wave_sum(s) * (1.f / DM); float s2 = 0.f;
#pragma unroll
        for (int j = 0; j < 4; ++j) { v[j] = v[j] - mean; s2 += (v[j].x * v[j].x + v[j].y * v[j].y) + (v[j].z * v[j].z + v[j].w * v[j].w); }
        const float rstd = 1.f / sqrtf(wave_sum(s2) * (1.f / DM) + LN_EPS);
        f32x4* of = (f32x4*)(XF + (size_t)m * DM) + lane; u32x2* ob = (u32x2*)(XB + (size_t)m * DM) + lane;
#pragma unroll
        for (int j = 0; j < 4; ++j) { const f32x4 gv = ((const f32x4*)g)[lane + 64 * j], bv = ((const f32x4*)b)[lane + 64 * j]; const f32x4 o = v[j] * rstd * gv + bv;
            of[64 * j] = o; u32x2 w; w.x = pk2(o.x, o.y); w.y = pk2(o.z, o.w); ob[64 * j] = w; }
    }
}

#define MFMA16(a, b, c) __builtin_amdgcn_mfma_f32_16x16x32_bf16((a), (b), (c), 0, 0, 0)

__device__ __forceinline__ void attn_phase(LAS unsigned char* lds, const bf16* Q, const bf16* K, const bf16* VT, bf16* MG, const float* rpb, const float* g_attn, int G, int bid, int wave, int lane) {
    LAS float* rp = (LAS float*)(lds + wave * 16384);
    LAS float* ssq = (LAS float*)(lds + LDS_MISC);
    const int h = wave, qi = lane & 15, g = lane >> 4;
    for (int i = lane; i < 465; i += 64) rp[i] = rpb[h * 465 + i];
    LDS_WAIT(); asm volatile("" ::: "memory");
    int par = 0;
    for (int unit = bid; unit < 512; unit += G) {
        const int b = unit >> 7, r = unit & 127;
        const int r0 = min(max(r - 4, 0), 120);
#pragma unroll 1
        for (int j = 0; j < 4; ++j) {
            const int kc0 = min(max(16 * j - 8, 0), 32);
            const int qc = 16 * j + qi;
            const int c0 = min(max(qc - 8, 0), 48);
            const size_t qtok = (size_t)b * SEQ + 64 * r + qc;
            bf16x8 qf[2];
#pragma unroll
            for (int kk = 0; kk < 2; ++kk) qf[kk] = *(const bf16x8*)(Q + qtok * 512 + h * 64 + 32 * kk + 8 * g);
            f32x4 sc[8][2];
#pragma unroll
            for (int n = 0; n < 8; ++n)
#pragma unroll
                for (int t = 0; t < 2; ++t) {
                    const size_t ktok = (size_t)b * SEQ + (r0 + n) * 64 + kc0 + 16 * t + qi;
                    const bf16x8 k0 = *(const bf16x8*)(K + ktok * 512 + h * 64 + 8 * g), k1 = *(const bf16x8*)(K + ktok * 512 + h * 64 + 32 + 8 * g);
                    f32x4 a = (f32x4){0.f, 0.f, 0.f, 0.f};
                    a = MFMA16(k0, qf[0], a); a = MFMA16(k1, qf[1], a);
                    sc[n][t] = a;
                }
            float mx = -3.0e38f;
#pragma unroll
            for (int n = 0; n < 8; ++n)
#pragma unroll
                for (int t = 0; t < 2; ++t)
#pragma unroll
                    for (int e = 0; e < 4; ++e) {
                        const int kc = kc0 + 16 * t + 4 * g + e; const bool inw = (kc >= c0) && (kc < c0 + 16);
                        const int dci = min(max(kc - qc, -15), 15) + 15;
                        const float bias = rp[(r0 + n - r + 7) * 31 + dci];
                        const float s = inw ? (sc[n][t][e] + bias) : -1.0e30f;
                        sc[n][t][e] = s; mx = fmaxf(mx, s);
                    }
            mx = fmaxf(mx, __shfl_xor(mx, 16)); mx = fmaxf(mx, __shfl_xor(mx, 32));
            float sum = 0.f;
#pragma unroll
            for (int n = 0; n < 8; ++n)
#pragma unroll
                for (int t = 0; t < 2; ++t)
#pragma unroll
                    for (int e = 0; e < 4; ++e) { const float p = __builtin_amdgcn_exp2f((sc[n][t][e] - mx) * 1.44269504089f); sc[n][t][e] = p; sum += p; }
            sum += __shfl_xor(sum, 16); sum += __shfl_xor(sum, 32);
            f32x4 o[4];
#pragma unroll
            for (int dt = 0; dt < 4; ++dt) o[dt] = (f32x4){0.f, 0.f, 0.f, 0.f};
#pragma unroll
            for (int n = 0; n < 8; ++n) {
                u32x4 pw; pw.x = pk2(sc[n][0][0], sc[n][0][1]); pw.y = pk2(sc[n][0][2], sc[n][0][3]); pw.z = pk2(sc[n][1][0], sc[n][1][1]); pw.w = pk2(sc[n][1][2], sc[n][1][3]);
                const bf16x8 pf = __builtin_bit_cast(bf16x8, pw);
#pragma unroll
                for (int dt = 0; dt < 4; ++dt) {
                    const bf16* vb = VT + ((size_t)((b * 8 + h) * 64 + 16 * dt + qi)) * SEQ + (r0 + n) * 64 + kc0 + 4 * g;
                    const u32x2 lo = *(const u32x2*)vb, hi = *(const u32x2*)(vb + 16);
                    u32x4 vw; vw.x = lo.x; vw.y = lo.y; vw.z = hi.x; vw.w = hi.y;
                    o[dt] = MFMA16(__builtin_bit_cast(bf16x8, vw), pf, o[dt]);
                }
            }
            const float inv = 1.0f / sum; float part = 0.f;
#pragma unroll
            for (int dt = 0; dt < 4; ++dt) { o[dt] = o[dt] * inv; part += (o[dt].x * o[dt].x + o[dt].y * o[dt].y) + (o[dt].z * o[dt].z + o[dt].w * o[dt].w); }
            part += __shfl_xor(part, 16); part += __shfl_xor(part, 32);
            if (g == 0) ssq[par * 128 + h * 16 + qi] = part;
            __syncthreads();
            float tot = 0.f;
#pragma unroll
            for (int hh = 0; hh < 8; ++hh) tot += ssq[par * 128 + hh * 16 + qi];
            par ^= 1;
            const float rstd = 1.0f / sqrtf(tot * (1.0f / 512.0f) + RMS_EPS);
#pragma unroll
            for (int dt = 0; dt < 4; ++dt) { const f32x4 gv = *(const f32x4*)(g_attn + h * 64 + 16 * dt + 4 * g); const f32x4 v = o[dt] * rstd * gv;
                u32x2 w; w.x = pk2(v.x, v.y); w.y = pk2(v.z, v.w); *(u32x2*)(MG + qtok * DM + h * 64 + 16 * dt + 4 * g) = w; }
        }
    }
    __syncthreads();
}

__device__ __forceinline__ void four0_phase(const bf16* U, const bf16* F0t, bf16* Z1, int gw, int NGW, int lane) {
    const int qi = lane & 15, g = lane >> 4;
    for (int unit = gw; unit < 2048; unit += NGW) {
        const int b = unit >> 9, gq = (unit >> 7) & 3, s2 = unit & 127;
        bf16x8 af[4][4];
#pragma unroll
        for (int a = 0; a < 4; ++a)
#pragma unroll
            for (int kk = 0; kk < 4; ++kk) { const size_t tok = (size_t)b * SEQ + 128 * (16 * a + qi) + s2; af[a][kk] = *(const bf16x8*)(U + tok * 512 + gq * 128 + 32 * kk + 8 * g); }
#pragma unroll 2
        for (int nt = 0; nt < 16; ++nt) {
            bf16x8 bfr[4];
#pragma unroll
            for (int kk = 0; kk < 4; ++kk) bfr[kk] = *(const bf16x8*)(F0t + (16 * nt + qi) * 128 + 32 * kk + 8 * g);
            const int n = 16 * nt + qi, ri = n >> 7, cp = n & 127;
            bf16* zp = Z1 + ((((size_t)(b * 4 + gq) * 128 + s2) * 128 + cp) * 2 + ri) * 64 + 4 * g;
#pragma unroll
            for (int a = 0; a < 4; ++a) { f32x4 acc = (f32x4){0.f, 0.f, 0.f, 0.f};
#pragma unroll
                for (int kk = 0; kk < 4; ++kk) acc = MFMA16(af[a][kk], bfr[kk], acc);
                u32x2 w; w.x = pk2(acc.x, acc.y); w.y = pk2(acc.z, acc.w); *(u32x2*)(zp + 16 * a) = w; }
        }
    }
}
__device__ __forceinline__ void four1_phase(const bf16* Z1, const bf16* F1t, const float* TW, bf16* T2, int gw, int NGW, int lane) {
    const int qi = lane & 15, g = lane >> 4;
    for (int unit = gw; unit < 4096; unit += NGW) {
        const int b = unit >> 10, gq = (unit >> 8) & 3, cp = (unit >> 1) & 127, hf = unit & 1;
        bf16x8 af[4][4];
#pragma unroll
        for (int a = 0; a < 4; ++a)
#pragma unroll
            for (int kk = 0; kk < 4; ++kk) { const int s2 = 16 * (4 * hf + a) + qi; af[a][kk] = *(const bf16x8*)(Z1 + (((size_t)(b * 4 + gq) * 128 + s2) * 128 + cp) * 128 + 32 * kk + 8 * g); }
#pragma unroll 1
        for (int nt = 0; nt < 4; ++nt) {
            bf16x8 bre[4], bim[4];
#pragma unroll
            for (int kk = 0; kk < 4; ++kk) { bre[kk] = *(const bf16x8*)(F1t + (16 * nt + qi) * 128 + 32 * kk + 8 * g); bim[kk] = *(const bf16x8*)(F1t + (64 + 16 * nt + qi) * 128 + 32 * kk + 8 * g); }
            const int s1p = 16 * nt + qi;
            bf16* tp = T2 + (((size_t)(b * 4 + gq) * 128 + cp) * 64 + s1p) * 256;
#pragma unroll
            for (int a = 0; a < 4; ++a) { f32x4 ar = (f32x4){0.f, 0.f, 0.f, 0.f}, ai = (f32x4){0.f, 0.f, 0.f, 0.f};
#pragma unroll
                for (int kk = 0; kk < 4; ++kk) { ar = MFMA16(af[a][kk], bre[kk], ar); ai = MFMA16(af[a][kk], bim[kk], ai); }
                const int s2b = 16 * (4 * hf + a) + 4 * g;
                const f32x4 t0 = *(const f32x4*)(TW + (size_t)(s1p * 128 + s2b) * 2), t1 = *(const f32x4*)(TW + (size_t)(s1p * 128 + s2b) * 2 + 4);
                const float c_[4] = {t0.x, t0.z, t1.x, t1.z}, s_[4] = {t0.y, t0.w, t1.y, t1.w};
                float re[4], im[4];
#pragma unroll
                for (int e = 0; e < 4; ++e) { re[e] = ar[e] * c_[e] + ai[e] * s_[e]; im[e] = ai[e] * c_[e] - ar[e] * s_[e]; }
                u32x2 w; w.x = pk2(re[0], re[1]); w.y = pk2(re[2], re[3]); *(u32x2*)(tp + s2b) = w;
                w.x = pk2(im[0], im[1]); w.y = pk2(im[2], im[3]); *(u32x2*)(tp + 128 + s2b) = w; }
        }
    }
}
__device__ __forceinline__ void four2_phase(LAS unsigned char* lds, const bf16* T2, const bf16* F2t, bf16* MG, const float* g_f, int G, int bid, int wave, int lane) {
    LAS float* ssq = (LAS float*)(lds + LDS_MISC);
    const int qi = lane & 15, g = lane >> 4, gq = wave >> 1, hf = wave & 1;
    for (int unit = bid; unit < 256; unit += G) {
        const int b = unit >> 6, s1p = unit & 63;
        f32x4 acc[4][8];
#pragma unroll
        for (int a = 0; a < 4; ++a)
#pragma unroll
            for (int nt = 0; nt < 8; ++nt) acc[a][nt] = (f32x4){0.f, 0.f, 0.f, 0.f};
#pragma unroll 1
        for (int kk = 0; kk < 8; ++kk) {
            bf16x8 af[4];
#pragma unroll
            for (int a = 0; a < 4; ++a) { const int cp = 16 * (4 * hf + a) + qi; af[a] = *(const bf16x8*)(T2 + (((size_t)(b * 4 + gq) * 128 + cp) * 64 + s1p) * 256 + 32 * kk + 8 * g); }
#pragma unroll
            for (int nt = 0; nt < 8; ++nt) { const bf16x8 bfr = *(const bf16x8*)(F2t + (16 * nt + qi) * 256 + 32 * kk + 8 * g);
#pragma unroll
                for (int a = 0; a < 4; ++a) acc[a][nt] = MFMA16(af[a], bfr, acc[a][nt]); }
        }
#pragma unroll
        for (int nt = 0; nt < 8; ++nt) { float part = 0.f;
#pragma unroll
            for (int a = 0; a < 4; ++a) part += (acc[a][nt].x * acc[a][nt].x + acc[a][nt].y * acc[a][nt].y) + (acc[a][nt].z * acc[a][nt].z + acc[a][nt].w * acc[a][nt].w);
            part += __shfl_xor(part, 16); part += __shfl_xor(part, 32);
            if (g == 0) ssq[wave * 128 + 16 * nt + qi] = part; }
        __syncthreads();
        float rstd[8];
#pragma unroll
        for (int nt = 0; nt < 8; ++nt) { float tot = 0.f;
#pragma unroll
            for (int w = 0; w < 8; ++w) tot += ssq[w * 128 + 16 * nt + qi];
            rstd[nt] = 1.0f / sqrtf(tot * (1.0f / 512.0f) + RMS_EPS); }
        __syncthreads();
#pragma unroll
        for (int a = 0; a < 4; ++a) { const int c4 = gq * 128 + 16 * (4 * hf + a) + 4 * g; const f32x4 gv = *(const f32x4*)(g_f + c4);
#pragma unroll
            for (int nt = 0; nt < 8; ++nt) { const size_t tok = (size_t)b * SEQ + s1p + 64 * (16 * nt + qi); const f32x4 v = acc[a][nt] * rstd[nt] * gv;
                u32x2 w; w.x = pk2(v.x, v.y); w.y = pk2(v.z, v.w); *(u32x2*)(MG + tok * DM + 512 + c4) = w; } }
    }
}

typedef __attribute__((address_space(1))) unsigned gu32;
constexpr size_t WS_CTL = 1 * MiB, CTL_ZERO_BYTES = 16384;
#define XB_TMO      128
#define XB_XCNT(j)  (256  + 64 * (j))
#define XB_XSUB(j)  (1280 + 64 * (j))
#define XB_XGEN(j)  (2304 + 64 * (j))
#define XB_TOP      3328
#define XB_TOPGEN   3392
#define XCD_BAR_WORDS 3456
#define XB_SPIN_CAP (1u << 18)

__device__ __forceinline__ unsigned xb_ld(unsigned* p)              { return __hip_atomic_load(p, __ATOMIC_RELAXED, __HIP_MEMORY_SCOPE_AGENT); }
__device__ __forceinline__ unsigned xb_add(unsigned* p, unsigned v) { return __hip_atomic_fetch_add(p, v, __ATOMIC_RELAXED, __HIP_MEMORY_SCOPE_AGENT); }
__device__ __forceinline__ unsigned xb_xcc_id() { return (unsigned)__builtin_amdgcn_s_getreg((3 << 11) | 20) & 0xFu; }
#define XB_SPIN(cond, bar) do { unsigned _sp = 0; while (cond) { __builtin_amdgcn_s_sleep(1); \
    if ((++_sp & 255u) == 0u) { if (xb_ld(&(bar)[XB_TMO])) break; if (_sp > XB_SPIN_CAP) { atomicAdd(&(bar)[XB_TMO], 1u); break; } } } } while (0)

struct XcdBarrier {
    unsigned* bar; unsigned x;
    volatile LAS unsigned* st;
};

__device__ __forceinline__ XcdBarrier xcd_barrier_post(unsigned* bar, volatile LAS unsigned* st) {
    XcdBarrier b; b.bar = bar; b.x = xb_xcc_id(); b.st = st;
    if (threadIdx.x == 0) (void)xb_add(&bar[XB_XCNT(b.x)], 1u);
    return b;
}
__device__ __forceinline__ void xcd_barrier_complete(unsigned* bar, unsigned x, unsigned& nloc, unsigned& nx) {
    const unsigned G = gridDim.x * gridDim.y * gridDim.z;
    unsigned sum, cnt, mine, sp = 0u;
    for (;;) {
        sum = 0u; cnt = 0u; mine = 0u;
#pragma unroll
        for (unsigned j = 0; j < 16; ++j) { const unsigned c = xb_ld(&bar[XB_XCNT(j)]); sum += c; cnt += (c > 0u) ? 1u : 0u; mine = (j == x) ? c : mine; }
        if (sum == G) break;
        __builtin_amdgcn_s_sleep(1);
        if ((++sp & 255u) == 0u) { if (xb_ld(&bar[XB_TMO])) break; if (sp > XB_SPIN_CAP) { atomicAdd(&bar[XB_TMO], 1u); break; } }
    }
    nloc = mine > 0u ? mine : 1u; nx = cnt > 0u ? cnt : 1u;
}

__device__ __forceinline__ void xcd_barrier(const XcdBarrier& b) {
    asm volatile("s_waitcnt vmcnt(0)" ::: "memory");
    __syncthreads();
    if (threadIdx.x == 0) {
        unsigned* bar = b.bar;
        __builtin_amdgcn_s_waitcnt(0);
        unsigned nloc = b.st[0], nx = b.st[1];
        if (nloc == 0u) { xcd_barrier_complete(bar, b.x, nloc, nx); b.st[0] = nloc; b.st[1] = nx; }
        const unsigned old = xb_add(&bar[XB_XSUB(b.x)], 1u);
        const unsigned gen = old / nloc;
        if (old + 1u == (gen + 1u) * nloc) {
            __builtin_amdgcn_fence(__ATOMIC_RELEASE, "agent");
            asm volatile("s_waitcnt vmcnt(0)" ::: "memory");
            const unsigned og = xb_add(&bar[XB_TOP], 1u);
            const unsigned tg = og / nx;
            if (og + 1u == (tg + 1u) * nx) xb_add(&bar[XB_TOPGEN], 1u);
            else XB_SPIN(xb_ld(&bar[XB_TOPGEN]) == tg, bar);
            __builtin_amdgcn_fence(__ATOMIC_ACQUIRE, "agent");
            xb_add(&bar[XB_XGEN(b.x)], 1u);
            asm volatile("s_waitcnt vmcnt(0)" ::: "memory");
        } else {
            XB_SPIN(xb_ld(&bar[XB_XGEN(b.x)]) == gen, bar);
            __builtin_amdgcn_fence(__ATOMIC_ACQUIRE, "agent");
            asm volatile("s_waitcnt vmcnt(0)" ::: "memory");
        }
    }
    __syncthreads();
}

struct Args { const float* in[18]; float* out; unsigned char* ws; int ph_lo, ph_hi, single, stop; };

typedef const __attribute__((address_space(4))) Args* KArgs;
__device__ __forceinline__ KArgs kargs() { KArgs p = (KArgs)__builtin_amdgcn_kernarg_segment_ptr(); asm volatile("" : "+s"(p)); return p; }
#define WSP(off) ((bf16*)(A->ws + (off)))

__global__ void __launch_bounds__(NWAVES * 64, 2) fwd_megakernel(Args a_unused) {
    extern __shared__ __attribute__((aligned(16))) unsigned char lds_raw[];
    LAS unsigned char* lds = (LAS unsigned char*)lds_raw;
    const int G = gridDim.x, bid = blockIdx.x;
    int ph = 0; int ph_lo, ph_hi, single, stop;
    { KArgs A = kargs(); ph_lo = A->ph_lo; ph_hi = A->ph_hi; single = A->single; stop = A->stop; }
    volatile LAS unsigned* bst = (volatile LAS unsigned*)(lds + LDS_MISC + 8192);
    if (threadIdx.x < 2) bst[threadIdx.x] = 0u;
    __syncthreads();
    XcdBarrier bar; bar.bar = nullptr; bar.x = 0; bar.st = nullptr;
    if (single) { KArgs A = kargs(); bar = xcd_barrier_post((unsigned*)(A->ws + WS_CTL), bst);
        cg::this_grid().sync(); }
#define RUN (ph >= ph_lo && ph < ph_hi && ph < stop)
#define SEAM() do { if (single) xcd_barrier(bar); ++ph; } while (0)
#define IDS() int tid_ = threadIdx.x; asm volatile("" : "+v"(tid_)); const int tid = tid_, lane = tid & 63, wave = __builtin_amdgcn_readfirstlane(tid >> 6), gw = bid * NWAVES + wave, NGW = G * NWAVES; (void)lane; (void)gw; (void)NGW; (void)tid

    if (RUN) {
        KArgs A = kargs(); IDS();
        bf16* WB = WSP(WS_W); bf16* XB = WSP(WS_XB);
        bf16* F0t = WSP(WS_TAB + TAB_F0); bf16* F1t = WSP(WS_TAB + TAB_F1); bf16* F2t = WSP(WS_TAB + TAB_F2); float* TW = (float*)WSP(WS_TAB + TAB_TW);
        LAS float* scr = (LAS float*)(lds + wave * 16384);
        constexpr int I_G = 16 * 88, I_D = 44 * 32, I_IN = 16 * 64, I_OUT = 16 * 32, I_L = 4 * I_G + 2 * I_D + I_IN + I_OUT;
        for (int it = gw; it < NLAYER * I_L; it += NGW) {
            const int l = it / I_L; int r = it % I_L; bf16* wl = WB + (size_t)l * WL_END;
            if (r < I_G) { p0_transpose_item(A->in[1] + (size_t)l * DM * DFF, DM, DFF, wl + WL_GU1, 1, scr, r, lane); continue; } r -= I_G;
            if (r < I_G) { p0_transpose_item(A->in[2] + (size_t)l * DM * DFF, DM, DFF, wl + WL_GU1, 2, scr, r, lane); continue; } r -= I_G;
            if (r < I_D) { p0_transpose_item(A->in[3] + (size_t)l * DFF * DM, DFF, DM, wl + WL_D1, 0, scr, r, lane); continue; } r -= I_D;
            if (r < I_IN) { p0_transpose_item(A->in[6] + (size_t)l * DM * 2048, DM, 2048, wl + WL_IN, 0, scr, r, lane); continue; } r -= I_IN;
            if (r < I_OUT) { p0_transpose_item(A->in[10] + (size_t)l * DM * DM, DM, DM, wl + WL_OUT, 0, scr, r, lane); continue; } r -= I_OUT;
            if (r < I_G) { p0_transpose_item(A->in[13] + (size_t)l * DM * DFF, DM, DFF, wl + WL_GU2, 1, scr, r, lane); continue; } r -= I_G;
            if (r < I_G) { p0_transpose_item(A->in[14] + (size_t)l * DM * DFF, DM, DFF, wl + WL_GU2, 2, scr, r, lane); continue; } r -= I_G;
            p0_transpose_item(A->in[15] + (size_t)l * DFF * DM, DFF, DM, wl + WL_D2, 0, scr, r, lane);
        }
        const float* xin = A->in[0];
        for (int m = gw; m < MTOK; m += NGW) {
            const f32x4* xr = (const f32x4*)(xin + (size_t)m * DM) + lane; u32x2* ob = (u32x2*)(XB + (size_t)m * DM) + lane;
#pragma unroll
            for (int j = 0; j < 4; ++j) { const f32x4 v = xr[64 * j]; u32x2 w; w.x = pk2(v.x, v.y); w.y = pk2(v.z, v.w); ob[64 * j] = w; }
        }
        for (int i = bid * 512 + tid; i < 32768 + 16384 + 32768 + 8192; i += G * 512) {
            float sn, cs;
            if (i < 32768) { const int n = i >> 7, c = i & 127, ri = n >> 7, cp = n & 127; sincospif((float)((c * cp) & 127) * (1.0f / 64.0f), &sn, &cs); F0t[i] = (bf16)f2bf((ri == 0 ? cs : -sn) * 0.125f); }
            else if (i < 49152) { const int e = i - 32768, n = e >> 7, k = e & 127, rip = n >> 6, s1p = n & 63, ri = k >> 6, s1 = k & 63; sincospif((float)((s1 * s1p) & 63) * (1.0f / 32.0f), &sn, &cs);
                const float v = (rip == ri) ? cs : (rip == 0 ? sn : -sn); F1t[e] = (bf16)f2bf(v * 0.125f); }
            else if (i < 81920) { const int e = i - 49152, s2p = e >> 8, k = e & 255, ri = k >> 7, s2 = k & 127; sincospif((float)((s2 * s2p) & 127) * (1.0f / 64.0f), &sn, &cs); F2t[e] = (bf16)f2bf((ri == 0 ? cs : sn) * 0.0625f); }
            else { const int e = i - 81920, s1p = e >> 7, s2 = e & 127; sincospif((float)(s1p * s2) * (1.0f / 4096.0f), &sn, &cs); TW[2 * e] = cs; TW[2 * e + 1] = sn; }
        }
    }
    SEAM();

#pragma unroll 1
    for (int i = 0; i < 2 * NLAYER; ++i) {
        const int l = i >> 1, f = i & 1;
        if (f == 1) {
            if (RUN) { KArgs A = kargs(); pg8::Gemm gm{WSP(WS_XB), WSP(WS_W) + (size_t)l * WL_END + WL_IN, MTOK, 2048, DM}; pg8::StaticOrder S; S.init(MTOK, 2048, G, bid); EpiProj E{WSP(WS_Q)};
                pg8::gemm_phase<EpiProj, pg8::StaticOrder>(lds, gm, S, E, nullptr); }
            SEAM();
            if (RUN) { KArgs A = kargs(); IDS();
                attn_phase(lds, WSP(WS_Q), WSP(WS_K), WSP(WS_VT), WSP(WS_MG), A->in[7] + (size_t)l * 8 * 465, A->in[8] + (size_t)l * 512, G, bid, wave, lane);
                four0_phase(WSP(WS_U), WSP(WS_TAB + TAB_F0), WSP(WS_Z1), gw, NGW, lane); }
            SEAM();
            if (RUN) { KArgs A = kargs(); IDS(); four1_phase(WSP(WS_Z1), WSP(WS_TAB + TAB_F1), (const float*)WSP(WS_TAB + TAB_TW), WSP(WS_T2), gw, NGW, lane); }
            SEAM();
            if (RUN) { KArgs A = kargs(); IDS(); four2_phase(lds, WSP(WS_T2), WSP(WS_TAB + TAB_F2), WSP(WS_MG), A->in[9] + (size_t)l * 512, G, bid, wave, lane); }
            SEAM();
            if (RUN) { KArgs A = kargs(); pg8::Gemm gm{WSP(WS_MG), WSP(WS_W) + (size_t)l * WL_END + WL_OUT, MTOK, DM, DM}; pg8::StaticOrder S; S.init(MTOK, DM, G, bid); EpiResid E{A->out, A->out, 1.0f};
                pg8::gemm_phase<EpiResid, pg8::StaticOrder>(lds, gm, S, E, nullptr); }
            SEAM();
            if (RUN) { KArgs A = kargs(); IDS(); ln_rows(A->out, A->out, WSP(WS_XB), A->in[11] + (size_t)l * DM, A->in[12] + (size_t)l * DM, gw, NGW, lane); }
            SEAM();
        }
        if (RUN) { KArgs A = kargs(); pg8::Gemm gm{WSP(WS_XB), WSP(WS_W) + (size_t)l * WL_END + (f ? WL_GU2 : WL_GU1), MTOK, 2 * DFF, DM}; pg8::StaticOrder S; S.init(MTOK, 2 * DFF, G, bid); EpiSwiGLU E{WSP(WS_H)};
            pg8::gemm_phase<EpiSwiGLU, pg8::StaticOrder>(lds, gm, S, E, nullptr); }
        SEAM();
        if (RUN) { KArgs A = kargs(); pg8::Gemm gm{WSP(WS_H), WSP(WS_W) + (size_t)l * WL_END + (f ? WL_D2 : WL_D1), MTOK, DM, DFF}; pg8::StaticOrder S; S.init(MTOK, DM, G, bid);
            const float* src = A->out; if (i == 0) src = A->in[0];
            EpiResid E{src, A->out, 0.5f};
            pg8::gemm_phase<EpiResid, pg8::StaticOrder>(lds, gm, S, E, nullptr); }
        SEAM();
        if (RUN) { KArgs A = kargs(); IDS(); const float* gp = f ? A->in[16] : A->in[4]; const float* bp = f ? A->in[17] : A->in[5];
            ln_rows(A->out, A->out, WSP(WS_XB), gp + (size_t)l * DM, bp + (size_t)l * DM, gw, NGW, lane); }
        SEAM();
    }
#if MK_STOP < 25
    if (ph >= ph_lo && ph < ph_hi) {
        KArgs A = kargs(); const unsigned short* w16 = (const unsigned short*)A->ws; float* o = A->out;
        for (size_t i = (size_t)bid * 512 + threadIdx.x; i < (size_t)MTOK * DM; i += (size_t)G * 512) {
            float h = 0.f;
            for (int k = 0; k < 7; ++k) { const size_t j = i + (size_t)k * 33554432u; if (j < WS_END / 2) h += (float)w16[j]; }
            const unsigned b = __builtin_bit_cast(unsigned, o[i]);
            o[i] = h + (float)(b >> 16) + (float)(b & 0xffffu);
        }
    }
#endif
}
constexpr int N_PHASES = 1 + NLAYER * (3 + 6 + 3);

#ifndef MK_MULTI
#define MK_MULTI 1
#endif
extern "C" void kernel_launch(void* const* d_in, const int* in_sizes, int n_in, void* d_out, int out_size, void* d_ws, size_t ws_size, hipStream_t stream) {
    static int grid = 0;
    if (grid == 0) {
        if (n_in != 18 || out_size != MTOK * DM || ws_size < WS_END) { fprintf(stderr, "kernel_launch: unexpected shapes (n_in %d out %d ws %zu)\n", n_in, out_size, ws_size); grid = -1; return; }
        int dev = 0, cus = 0, per_cu = 0;
        (void)hipGetDevice(&dev); (void)hipDeviceGetAttribute(&cus, hipDeviceAttributeMultiprocessorCount, dev);
        if (hipFuncSetAttribute((const void*)fwd_megakernel, hipFuncAttributeMaxDynamicSharedMemorySize, LDS_BYTES) != hipSuccess) { fprintf(stderr, "kernel_launch: hipFuncSetAttribute failed\n"); grid = -1; return; }
        if (hipOccupancyMaxActiveBlocksPerMultiprocessor(&per_cu, (const void*)fwd_megakernel, NWAVES * 64, LDS_BYTES) != hipSuccess || per_cu < 1) { fprintf(stderr, "kernel_launch: occupancy query says %d\n", per_cu); per_cu = 1; }
        (void)hipGetLastError();
        grid = cus;
    }
    if (grid < 0) return;
    if (hipMemsetAsync((char*)d_ws + WS_CTL, 0, CTL_ZERO_BYTES, stream) != hipSuccess) { fprintf(stderr, "kernel_launch: memset failed\n"); return; }
    Args a{};
    for (int i = 0; i < 18; ++i) a.in[i] = (const float*)d_in[i];
    a.out = (float*)d_out; a.ws = (unsigned char*)d_ws;
#if MK_MULTI
    a.stop = MK_STOP;
    for (int p = 0; p < N_PHASES + (MK_STOP < 25 ? 1 : 0); ++p) { a.ph_lo = p; a.ph_hi = p + 1; a.single = 0; hipLaunchKernelGGL(fwd_megakernel, dim3(grid), dim3(NWAVES * 64), LDS_BYTES, stream, a); }
#else
    a.ph_lo = 0; a.ph_hi = N_PHASES + 1; a.single = 1; a.stop = MK_STOP;
    void* args[] = {&a};
    hipError_t e = hipLaunchCooperativeKernel((const void*)fwd_megakernel, dim3(grid), dim3(NWAVES * 64), args, LDS_BYTES, stream);
    if (e != hipSuccess) fprintf(stderr, "kernel_launch: cooperative launch failed: %s (grid %d)\n", hipGetErrorString(e), grid);
#endif
}
```

```cpp
#include <hip/hip_cooperative_groups.h>
#include <cstdio>
#include <cstdint>
namespace pg8 {
#define PG8_LAS __attribute__((address_space(3)))
typedef unsigned short bf16_t;
typedef short bf16x8 __attribute__((ext_vector_type(8)));
typedef float f32x4 __attribute__((ext_vector_type(4)));
typedef unsigned u32x4 __attribute__((ext_vector_type(4)));
constexpr int BM = 256, BK = 64, HALF = 128, HTB = HALF * BK * 2  , STAGE_BYTES = 8 * HTB, NXCD = 8, WGM = 8;

__host__ __device__ __forceinline__ int lds_byte(int r, int c) { const int st = (r >> 4) * 2 + (c >> 5), rr = r & 15, cc = c & 31, ob = rr * 64 + cc * 2; return st * 1024 + (ob ^ (((ob >> 9) & 1) << 5)); }
__host__ __device__ __forceinline__ void stage_rc(int b, int& R, int& C) { const int st = b / 1024, sb = b % 1024, swz = sb ^ (((sb >> 9) & 1) << 5); R = (st >> 1) * 16 + swz / 64; C = (st & 1) * 32 + (swz % 64) / 2; }
__host__ __device__ __forceinline__ int perm32(int rho) { const int n = rho >> 4, i = rho & 15; return 8 * (i >> 2) + 4 * n + (i & 3); }

struct Unit { int pm, pn; };
struct Gemm { const bf16_t* A; const bf16_t* Bt; int M, N, K; };

struct StaticOrder {
    int nM, nN, nwg, G, c;
    __host__ __device__ void init(int M, int N, int G_, int c_) { nM = M / BM; nN = N / BM; nwg = nM * nN; G = G_; c = c_; }
    __host__ __device__ bool next(int i, Unit& u) const {
        const long L = (long)i * G + c; if (L >= nwg) return false;
        int wgid = (int)L; { const int q = nwg / NXCD, r = nwg % NXCD, xcd = wgid % NXCD, off = wgid / NXCD; wgid = (xcd < r ? xcd * (q + 1) : r * (q + 1) + (xcd - r) * q) + off; }
        const int nig = WGM * nN, gid = wgid / nig, fm = gid * WGM, gsz = (nM - fm) < WGM ? (nM - fm) : WGM;
        u.pm = fm + ((wgid % nig) % gsz); u.pn = (wgid % nig) / gsz; return true;
    }
    __device__ __forceinline__ void a_ready(const Unit&) const {}
    __device__ __forceinline__ void done(const Unit&) const {}
};
__device__ __forceinline__ unsigned cvt_pk_bf16(float lo, float hi) { unsigned r; asm volatile("v_cvt_pk_bf16_f32 %0, %1, %2" : "=v"(r) : "v"(lo), "v"(hi)); return r; }
typedef float f32x2 __attribute__((ext_vector_type(2)));
template <class Epi, class Sched, bool STAMP = false>
__device__ __forceinline__ void gemm_phase(PG8_LAS unsigned char* lds, const Gemm g, const Sched& S, const Epi& E, unsigned long long* stamps) {
    int tid_ = threadIdx.x; asm volatile("" : "+v"(tid_));
    const int tid = tid_, wid = __builtin_amdgcn_readfirstlane(tid >> 6), lane = tid & 63, wr = wid >> 2, wc = wid & 3, fr = lane & 15, fq = lane >> 4;
    const int K = g.K, nt = K / BK;
    int ts_lo = 0, ts_hi = 0, nts = 0; const unsigned long long rt_entry = STAMP ? (unsigned long long)wall_clock64() : 0ull;
#define PG8_STAMP() do { if (STAMP && wid == 0 && nts < 64) { const unsigned long long _c = (unsigned long long)clock64(); \
        ts_lo = (lane == nts) ? (int)(unsigned)_c : ts_lo; ts_hi = (lane == nts) ? (int)(unsigned)(_c >> 32) : ts_hi; ++nts; } } while (0)
    PG8_STAMP();
    unsigned voffA[2], voffB[2];
#pragma unroll
    for (int i = 0; i < 2; ++i) { int R, C; stage_rc(tid * 16 + i * 8192, R, C); const int Rb = Epi::PERM ? ((R & ~31) + perm32(R & 31)) : R;
        voffA[i] = (unsigned)(R * K + C) * 2u; voffB[i] = (unsigned)(Rb * K + C) * 2u; }
    const size_t kstep = (size_t)(BK * 2);
    const size_t hstep = (size_t)HALF * K * 2;
    const size_t tstep = 2 * hstep;
    const unsigned ldsw = (unsigned)wid * 1024u;
    const int aoff = lds_byte(wr * 64 + fr, fq * 8), boff = lds_byte(wc * 32 + fr, fq * 8);
#define PG8_SA(b, h) (((b) * 2 + (h)) * HTB)
#define PG8_SB(b, h) ((4 + (b) * 2 + (h)) * HTB)
#define PG8_STAGE(bufoff, gbase, voff) do { _Pragma("unroll") for (int _i = 0; _i < 2; ++_i) \
        __builtin_amdgcn_global_load_lds((const unsigned*)((const char*)(gbase) + (voff)[_i]), (PG8_LAS unsigned*)(lds + (bufoff) + ldsw + _i * 8192), 16, 0, 0); } while (0)
#define PG8_LDA(dst, b, h) do { _Pragma("unroll") for (int m = 0; m < 4; ++m) _Pragma("unroll") for (int k = 0; k < 2; ++k) dst[m][k] = *(const PG8_LAS bf16x8*)(lds + PG8_SA(b, h) + aoff + m * 2048 + k * 1024); } while (0)
#define PG8_LDB(dst, b, h) do { _Pragma("unroll") for (int n = 0; n < 2; ++n) _Pragma("unroll") for (int k = 0; k < 2; ++k) dst[n][k] = *(const PG8_LAS bf16x8*)(lds + PG8_SB(b, h) + boff + n * 2048 + k * 1024); } while (0)
#define PG8_MMA(ai, bj, At, Bt) do { __builtin_amdgcn_s_setprio(1); _Pragma("unroll") for (int m = 0; m < 4; ++m) _Pragma("unroll") for (int n = 0; n < 2; ++n) _Pragma("unroll") for (int k = 0; k < 2; ++k) \
        acc[ai][bj][m][n] = __builtin_amdgcn_mfma_f32_16x16x32_bf16(Bt[n][k], At[m][k], acc[ai][bj][m][n], 0, 0, 0); __builtin_amdgcn_s_setprio(0); } while (0)
#define PG8_WAIT_V(n) asm volatile("s_waitcnt vmcnt(" #n ")" ::: "memory")
#define PG8_WAIT_L(n) asm volatile("s_waitcnt lgkmcnt(" #n ")" ::: "memory")
#define PG8_BAR __builtin_amdgcn_s_barrier()
#define PG8_SCHED __builtin_amdgcn_sched_barrier(0)
    Unit cur, nxt; int ui = 0;
    if (!S.next(0, cur)) return;
    f32x4 acc[2][2][4][2];
#pragma unroll
    for (int a = 0; a < 2; ++a)
#pragma unroll
        for (int b = 0; b < 2; ++b)
#pragma unroll
            for (int m = 0; m < 4; ++m)
#pragma unroll
                for (int n = 0; n < 2; ++n) acc[a][b][m][n] = (f32x4){0.f, 0.f, 0.f, 0.f};
    bf16x8 At[4][2], B0[2][2], B1[2][2];
    const char* cA = (const char*)g.A + (size_t)cur.pm * tstep; const char* cB = (const char*)g.Bt + (size_t)cur.pn * tstep;
    S.a_ready(cur);
    PG8_STAGE(PG8_SB(0, 0), cB, voffB); PG8_STAGE(PG8_SA(0, 0), cA, voffA); PG8_STAGE(PG8_SB(0, 1), cB + hstep, voffB); PG8_STAGE(PG8_SA(0, 1), cA + hstep, voffA);
    if (wr == 1) PG8_BAR;
    PG8_WAIT_V(4); PG8_BAR;
    PG8_STAGE(PG8_SB(1, 0), cB + kstep, voffB); PG8_STAGE(PG8_SA(1, 0), cA + kstep, voffA); PG8_STAGE(PG8_SB(1, 1), cB + hstep + kstep, voffB);
    PG8_WAIT_V(6); PG8_BAR;
    PG8_STAMP();
    for (;;) {
        const bool has_next = S.next(ui + 1, nxt);
        const char* nA = has_next ? (const char*)g.A + (size_t)nxt.pm * tstep : cA; const char* nB = has_next ? (const char*)g.Bt + (size_t)nxt.pn * tstep : cB;
        for (int t = 0; t < nt; t += 2) {
            const bool last = (t == nt - 2);
            const char* a1 = cA + (size_t)(t + 1) * kstep;
            const char* a2 = last ? nA : cA + (size_t)(t + 2) * kstep; const char* b2 = last ? nB : cB + (size_t)(t + 2) * kstep;
            const char* a3 = a2 + kstep; const char* b3 = b2 + kstep;
            if (last && has_next) S.a_ready(nxt);
            PG8_LDB(B0, 0, 0); PG8_SCHED; PG8_LDA(At, 0, 0); PG8_STAGE(PG8_SA(1, 1), a1 + hstep, voffA);
            PG8_WAIT_L(8); PG8_BAR; PG8_WAIT_L(0); PG8_MMA(0, 0, At, B0); PG8_BAR; PG8_SCHED;
            PG8_LDB(B1, 0, 1); PG8_STAGE(PG8_SB(0, 0), b2, voffB);
            PG8_BAR; PG8_WAIT_L(0); PG8_MMA(0, 1, At, B1); PG8_BAR;
            PG8_LDA(At, 0, 1); PG8_STAGE(PG8_SA(0, 0), a2, voffA);
            PG8_BAR; PG8_WAIT_L(0); PG8_MMA(1, 0, At, B0); PG8_BAR; PG8_SCHED;
            PG8_STAGE(PG8_SB(0, 1), b2 + hstep, voffB);
            PG8_WAIT_V(6); PG8_BAR; PG8_MMA(1, 1, At, B1); PG8_BAR;
            PG8_LDB(B0, 1, 0); PG8_SCHED; PG8_LDA(At, 1, 0); PG8_STAGE(PG8_SA(0, 1), a2 + hstep, voffA);
            PG8_WAIT_L(8); PG8_BAR; PG8_WAIT_L(0); PG8_MMA(0, 0, At, B0); PG8_BAR; PG8_SCHED;
            PG8_LDB(B1, 1, 1); PG8_STAGE(PG8_SB(1, 0), b3, voffB);
            PG8_BAR; PG8_WAIT_L(0); PG8_MMA(0, 1, At, B1); PG8_BAR;
            PG8_LDA(At, 1, 1); PG8_STAGE(PG8_SA(1, 0), a3, voffA);
            PG8_BAR; PG8_WAIT_L(0); PG8_MMA(1, 0, At, B0); PG8_BAR; PG8_SCHED;
            PG8_STAGE(PG8_SB(1, 1), b3 + hstep, voffB);
            PG8_WAIT_V(6); PG8_BAR; PG8_MMA(1, 1, At, B1); PG8_BAR;
        }
        PG8_STAMP();
        if constexpr (!Epi::AFTER_DRAIN) { E(acc, cur, wr, wc, fr, fq); S.done(cur); }
        PG8_STAMP();
        if (!has_next) break;
#pragma unroll
        for (int a = 0; a < 2; ++a)
#pragma unroll
            for (int b = 0; b < 2; ++b)
#pragma unroll
                for (int m = 0; m < 4; ++m)
#pragma unroll
                    for (int n = 0; n < 2; ++n) acc[a][b][m][n] = (f32x4){0.f, 0.f, 0.f, 0.f};
        cur = nxt; cA = nA; cB = nB; ++ui;
    }
    PG8_WAIT_V(0);
    if (wr == 0) PG8_BAR;
    PG8_BAR;
    if constexpr (Epi::AFTER_DRAIN) { E.fused(acc, cur, wr, wc, fr, fq, lds, wid, lane); S.done(cur); }
    PG8_STAMP();
    if (STAMP && wid == 0) { stamps[lane] = lane < nts ? (((unsigned long long)(unsigned)ts_hi << 32) | (unsigned)ts_lo) : 0ull;
        if (lane == 62) stamps[62] = rt_entry; if (lane == 63) stamps[63] = (unsigned long long)wall_clock64(); }
#undef PG8_STAMP
#undef PG8_SA
#undef PG8_SB
#undef PG8_STAGE
#undef PG8_LDA
#undef PG8_LDB
#undef PG8_MMA
#undef PG8_WAIT_V
#undef PG8_WAIT_L
#undef PG8_BAR
#undef PG8_SCHED
}
}

namespace cg = cooperative_groups;
#ifndef MK_STOP
#define MK_STOP 25
#endif

#define LAS __attribute__((address_space(3)))
typedef unsigned short bf16;
typedef float f32x4 __attribute__((ext_vector_type(4)));
typedef float f32x2 __attribute__((ext_vector_type(2)));
typedef short bf16x8 __attribute__((ext_vector_type(8)));
typedef unsigned u32x4 __attribute__((ext_vector_type(4)));
typedef unsigned u32x2 __attribute__((ext_vector_type(2)));

constexpr int NWAVES = 8;
constexpr int MTOK = 32768, DM = 1024, DFF = 2816, SEQ = 8192, NLAYER = 2;
constexpr float ALPHA = 1.41421356237309515f;
constexpr float LN_EPS = 1e-5f, RMS_EPS = 1e-6f;
constexpr int LDS_BYTES = 147456;
constexpr int LDS_MISC = 131072;

constexpr size_t MiB = 1u << 20;
constexpr size_t WS_TAB = 0;
constexpr size_t TAB_F0 = 0, TAB_F1 = 65536, TAB_F2 = 98304, TAB_TW = 163840;
constexpr size_t WS_W = 2 * MiB;
constexpr size_t W_GU = (size_t)5632 * 1024, W_D = (size_t)1024 * 2816, W_IN = (size_t)2048 * 1024, W_OUT = (size_t)1024 * 1024;
constexpr size_t WL_GU1 = 0, WL_D1 = WL_GU1 + W_GU, WL_IN = WL_D1 + W_D, WL_OUT = WL_IN + W_IN, WL_GU2 = WL_OUT + W_OUT, WL_D2 = WL_GU2 + W_GU, WL_END = WL_D2 + W_D;
static_assert(WS_W + 2 * WL_END * 2 <= 82 * MiB, "weights");
constexpr size_t WS_XB = 82 * MiB;
constexpr size_t WS_MG = 146 * MiB;
constexpr size_t WS_H = 210 * MiB;
constexpr size_t WS_Q = 210 * MiB, WS_K = 242 * MiB, WS_VT = 274 * MiB, WS_U = 306 * MiB, WS_Z1 = 338 * MiB, WS_T2 = 210 * MiB;
constexpr size_t WS_END = 402 * MiB;

__device__ __forceinline__ unsigned f2bf(float f) { unsigned u = __builtin_bit_cast(unsigned, f); return (u + 0x7fffu + ((u >> 16) & 1u)) >> 16; }
typedef __bf16 bf16v2 __attribute__((ext_vector_type(2)));
__device__ __forceinline__ unsigned pk2(float lo, float hi) { const f32x2 v = {lo, hi}; const bf16v2 b = __builtin_convertvector(v, bf16v2); return __builtin_bit_cast(unsigned, b); }
#define LDS_WAIT() asm volatile("s_waitcnt lgkmcnt(0)" ::: "memory")

struct EpiSwiGLU {
    static constexpr bool PERM = true, AFTER_DRAIN = false;
    bf16* H;
    __device__ __forceinline__ void operator()(const pg8::f32x4 (&acc)[2][2][4][2], const pg8::Unit& u, int wr, int wc, int fr, int fq) const {
        const int row0 = u.pm * 256 + wr * 64 + fr, col0 = u.pn * 128 + wc * 32 + 8 * fq;
#pragma unroll
        for (int ai = 0; ai < 2; ++ai)
#pragma unroll
            for (int m = 0; m < 4; ++m) {
                bf16* rowp = H + (size_t)(row0 + ai * 128 + m * 16) * DFF + col0;
                float hv[8];
#pragma unroll
                for (int n = 0; n < 2; ++n)
#pragma unroll
                    for (int e = 0; e < 4; ++e) { const float g = acc[ai][0][m][n][e], up = acc[ai][1][m][n][e];
                        const float sg = g * __builtin_amdgcn_rcpf(1.0f + __builtin_amdgcn_exp2f(g * -1.44269504089f)); hv[n * 4 + e] = sg * up; }
                u32x4 w; w.x = pk2(hv[0], hv[1]); w.y = pk2(hv[2], hv[3]); w.z = pk2(hv[4], hv[5]); w.w = pk2(hv[6], hv[7]);
                *(u32x4*)rowp = w;
            }
    }
};
struct EpiResid {
    static constexpr bool PERM = false, AFTER_DRAIN = false;
    const float* src; float* dst; float scale;
    __device__ __forceinline__ void operator()(const pg8::f32x4 (&acc)[2][2][4][2], const pg8::Unit& u, int wr, int wc, int fr, int fq) const {
        const int row0 = u.pm * 256 + wr * 64 + fr, col0 = u.pn * 256 + wc * 32 + 4 * fq;
#pragma unroll
        for (int ai = 0; ai < 2; ++ai)
#pragma unroll
            for (int m = 0; m < 4; ++m) { const size_t off = (size_t)(row0 + ai * 128 + m * 16) * DM + col0;
#pragma unroll
                for (int bj = 0; bj < 2; ++bj)
#pragma unroll
                    for (int n = 0; n < 2; ++n) { const f32x4 s = *(const f32x4*)(src + off + bj * 128 + n * 16); const f32x4 o = s * ALPHA + acc[ai][bj][m][n] * scale; *(f32x4*)(dst + off + bj * 128 + n * 16) = o; }
                asm volatile("" ::: "memory"); }
    }
};
struct EpiProj {
    static constexpr bool PERM = true, AFTER_DRAIN = false;
    bf16* P;
    __device__ __forceinline__ void operator()(const pg8::f32x4 (&acc)[2][2][4][2], const pg8::Unit& u, int wr, int wc, int fr, int fq) const {
        const int t = u.pn >> 1; const int row0 = u.pm * 256 + wr * 64 + fr, cl = (u.pn & 1) * 256 + wc * 32 + 8 * fq;
        if (t != 2) {
            bf16* base = P + (size_t)t * (16u << 20); const float sc = (t == 0) ? 0.125f : 1.0f;
#pragma unroll
            for (int ai = 0; ai < 2; ++ai)
#pragma unroll
                for (int m = 0; m < 4; ++m) { bf16* rowp = base + (size_t)(row0 + ai * 128 + m * 16) * 512 + cl;
#pragma unroll
                    for (int bj = 0; bj < 2; ++bj) { const f32x4 v0 = acc[ai][bj][m][0] * sc, v1 = acc[ai][bj][m][1] * sc;
                        u32x4 w; w.x = pk2(v0[0], v0[1]); w.y = pk2(v0[2], v0[3]); w.z = pk2(v1[0], v1[1]); w.w = pk2(v1[2], v1[3]);
                        *(u32x4*)(rowp + bj * 128) = w; } }
        } else {
            bf16* VT = P + (size_t)(32u << 20);
#pragma unroll
            for (int ai = 0; ai < 2; ++ai)
#pragma unroll
                for (int m = 0; m < 4; ++m) { const int row = row0 + ai * 128 + m * 16; const int b = row >> 13, s = row & 8191;
#pragma unroll
                    for (int bj = 0; bj < 2; ++bj)
#pragma unroll
                        for (int n = 0; n < 2; ++n)
#pragma unroll
                            for (int e = 0; e < 4; ++e) { const int col = cl + bj * 128 + n * 4 + e;
                                VT[((size_t)(b * 512 + col)) * SEQ + s] = (bf16)f2bf(acc[ai][bj][m][n][e]); } }
        }
    }
};

__device__ __forceinline__ float wave_sum(float v) {
#pragma unroll
    for (int o = 1; o < 64; o <<= 1) v += __shfl_xor(v, o);
    return v;
}
__device__ __forceinline__ void p0_transpose_item(const float* W, int K, int N, bf16* WT, int mode, LAS float* scr, int item, int lane) {
    const int nblk = N / 32, kb = item / nblk, nb = item % nblk, k0 = 64 * kb, n0 = 32 * nb;
    const int r0 = (mode == 0) ? n0 : (256 * (n0 >> 7) + (n0 & 127) + (mode == 2 ? 128 : 0));
#pragma unroll 8
    for (int i = 0; i < 32; ++i) { const int kk = 2 * i + (lane >> 5); scr[kk * 33 + (lane & 31)] = W[(size_t)(k0 + kk) * N + n0 + (lane & 31)]; }
    LDS_WAIT(); asm volatile("" ::: "memory");
    const int c = lane & 7;
#pragma unroll
    for (int j = 0; j < 4; ++j) { const int n = (lane >> 3) + 8 * j; const LAS float* s = scr + (8 * c) * 33 + n;
        u32x4 o; o.x = pk2(s[0 * 33], s[1 * 33]); o.y = pk2(s[2 * 33], s[3 * 33]); o.z = pk2(s[4 * 33], s[5 * 33]); o.w = pk2(s[6 * 33], s[7 * 33]);
        *(u32x4*)(WT + (size_t)(r0 + n) * K + k0 + 8 * c) = o; }
    LDS_WAIT(); asm volatile("" ::: "memory");
}
__device__ __forceinline__ void ln_rows(const float* Y, float* XF, bf16* XB, const float* g, const float* b, int gw, int NGW, int lane) {
    for (int m = gw; m < MTOK; m += NGW) {
        const f32x4* xr = (const f32x4*)(Y + (size_t)m * DM) + lane;
        f32x4 v[4]; float s = 0.f;
#pragma unroll
        for (int j = 0; j < 4; ++j) { v[j] = xr[64 * j]; s += (v[j].x + v[j].y) + (v[j].z + v[j].w); }
        const float mean = wave_sum(s) * (1.f / DM); float s2 = 0.f;
#pragma unroll
        for (int j = 0; j < 4; ++j) { v[j] = v[j] - mean; s2 += (v[j].x * v[j].x + v[j].y * v[j].y) + (v[j].z * v[j].z + v[j].w * v[j].w); }
        const float rstd = 1.f / sqrtf(wave_sum(s2) * (1.f / DM) + LN_EPS);
        f32x4* of = (f32x4*)(XF + (size_t)m * DM) + lane; u32x2* ob = (u32x2*)(XB + (size_t)m * DM) + lane;
#pragma unroll
        for (int j = 0; j < 4; ++j) { const f32x4 gv = ((const f32x4*)g)[lane + 64 * j], bv = ((const f32x4*)b)[lane + 64 * j]; const f32x4 o = v[j] * rstd * gv + bv;
            of[64 * j] = o; u32x2 w; w.x = pk2(o.x, o.y); w.y = pk2(o.z, o.w); ob[64 * j] = w; }
    }
}

#define MFMA16(a, b, c) __builtin_amdgcn_mfma_f32_16x16x32_bf16((a), (b), (c), 0, 0, 0)

__device__ __forceinline__ void attn_phase(LAS unsigned char* lds, const bf16* Q, const bf16* K, const bf16* VT, bf16* MG, const float* rpb, const float* g_attn, int G, int bid, int wave, int lane) {
    LAS float* rp = (LAS float*)(lds + wave * 16384);
    LAS float* ssq = (LAS float*)(lds + LDS_MISC);
    const int h = wave, qi = lane & 15, g = lane >> 4;
    for (int i = lane; i < 465; i += 64) rp[i] = rpb[h * 465 + i];
    LDS_WAIT(); asm volatile("" ::: "memory");
    int par = 0;
    for (int unit = bid; unit < 512; unit += G) {
        const int b = unit >> 7, r = unit & 127;
        const int r0 = min(max(r - 4, 0), 120);
#pragma unroll 1
        for (int j = 0; j < 4; ++j) {
            const int kc0 = min(max(16 * j - 8, 0), 32);
            const int qc = 16 * j + qi;
            const int c0 = min(max(qc - 8, 0), 48);
            const size_t qtok = (size_t)b * SEQ + 64 * r + qc;
            bf16x8 qf[2];
#pragma unroll
            for (int kk = 0; kk < 2; ++kk) qf[kk] = *(const bf16x8*)(Q + qtok * 512 + h * 64 + 32 * kk + 8 * g);
            f32x4 sc[8][2];
#pragma unroll
            for (int n = 0; n < 8; ++n)
#pragma unroll
                for (int t = 0; t < 2; ++t) {
                    const size_t ktok = (size_t)b * SEQ + (r0 + n) * 64 + kc0 + 16 * t + qi;
                    const bf16x8 k0 = *(const bf16x8*)(K + ktok * 512 + h * 64 + 8 * g), k1 = *(const bf16x8*)(K + ktok * 512 + h * 64 + 32 + 8 * g);
                    f32x4 a = (f32x4){0.f, 0.f, 0.f, 0.f};
                    a = MFMA16(k0, qf[0], a); a = MFMA16(k1, qf[1], a);
                    sc[n][t] = a;
                }
            float mx = -3.0e38f;
#pragma unroll
            for (int n = 0; n < 8; ++n)
#pragma unroll
                for (int t = 0; t < 2; ++t)
#pragma unroll
                    for (int e = 0; e < 4; ++e) {
                        const int kc = kc0 + 16 * t + 4 * g + e; const bool inw = (kc >= c0) && (kc < c0 + 16);
                        const int dci = min(max(kc - qc, -15), 15) + 15;
                        const float bias = rp[(r0 + n - r + 7) * 31 + dci];
                        const float s = inw ? (sc[n][t][e] + bias) : -1.0e30f;
                        sc[n][t][e] = s; mx = fmaxf(mx, s);
                    }
            mx = fmaxf(mx, __shfl_xor(mx, 16)); mx = fmaxf(mx, __shfl_xor(mx, 32));
            float sum = 0.f;
#pragma unroll
            for (int n = 0; n < 8; ++n)
#pragma unroll
                for (int t = 0; t < 2; ++t)
#pragma unroll
                    for (int e = 0; e < 4; ++e) { const float p = __builtin_amdgcn_exp2f((sc[n][t][e] - mx) * 1.44269504089f); sc[n][t][e] = p; sum += p; }
            sum += __shfl_xor(sum, 16); sum += __shfl_xor(sum, 32);
            f32x4 o[4];
#pragma unroll
            for (int dt = 0; dt < 4; ++dt) o[dt] = (f32x4){0.f, 0.f, 0.f, 0.f};
#pragma unroll
            for (int n = 0; n < 8; ++n) {
                u32x4 pw; pw.x = pk2(sc[n][0][0], sc[n][0][1]); pw.y = pk2(sc[n][0][2], sc[n][0][3]); pw.z = pk2(sc[n][1][0], sc[n][1][1]); pw.w = pk2(sc[n][1][2], sc[n][1][3]);
                const bf16x8 pf = __builtin_bit_cast(bf16x8, pw);
#pragma unroll
                for (int dt = 0; dt < 4; ++dt) {
                    const bf16* vb = VT + ((size_t)((b * 8 + h) * 64 + 16 * dt + qi)) * SEQ + (r0 + n) * 64 + kc0 + 4 * g;
                    const u32x2 lo = *(const u32x2*)vb, hi = *(const u32x2*)(vb + 16);
                    u32x4 vw; vw.x = lo.x; vw.y = lo.y; vw.z = hi.x; vw.w = hi.y;
                    o[dt] = MFMA16(__builtin_bit_cast(bf16x8, vw), pf, o[dt]);
                }
            }
            const float inv = 1.0f / sum; float part = 0.f;
#pragma unroll
            for (int dt = 0; dt < 4; ++dt) { o[dt] = o[dt] * inv; part += (o[dt].x * o[dt].x + o[dt].y * o[dt].y) + (o[dt].z * o[dt].z + o[dt].w * o[dt].w); }
            part += __shfl_xor(part, 16); part += __shfl_xor(part, 32);
            if (g == 0) ssq[par * 128 + h * 16 + qi] = part;
            __syncthreads();
            float tot = 0.f;
#pragma unroll
            for (int hh = 0; hh < 8; ++hh) tot += ssq[par * 128 + hh * 16 + qi];
            par ^= 1;
            const float rstd = 1.0f / sqrtf(tot * (1.0f / 512.0f) + RMS_EPS);
#pragma unroll
            for (int dt = 0; dt < 4; ++dt) { const f32x4 gv = *(const f32x4*)(g_attn + h * 64 + 16 * dt + 4 * g); const f32x4 v = o[dt] * rstd * gv;
                u32x2 w; w.x = pk2(v.x, v.y); w.y = pk2(v.z, v.w); *(u32x2*)(MG + qtok * DM + h * 64 + 16 * dt + 4 * g) = w; }
        }
    }
    __syncthreads();
}

__device__ __forceinline__ void four0_phase(const bf16* U, const bf16* F0t, bf16* Z1, int gw, int NGW, int lane) {
    const int qi = lane & 15, g = lane >> 4;
    for (int unit = gw; unit < 2048; unit += NGW) {
        const int b = unit >> 9, gq = (unit >> 7) & 3, s2 = unit & 127;
        bf16x8 af[4][4];
#pragma unroll
        for (int a = 0; a < 4; ++a)
#pragma unroll
            for (int kk = 0; kk < 4; ++kk) { const size_t tok = (size_t)b * SEQ + 128 * (16 * a + qi) + s2; af[a][kk] = *(const bf16x8*)(U + tok * 512 + gq * 128 + 32 * kk + 8 * g); }
#pragma unroll 2
        for (int nt = 0; nt < 16; ++nt) {
            bf16x8 bfr[4];
#pragma unroll
            for (int kk = 0; kk < 4; ++kk) bfr[kk] = *(const bf16x8*)(F0t + (16 * nt + qi) * 128 + 32 * kk + 8 * g);
            const int n = 16 * nt + qi, ri = n >> 7, cp = n & 127;
            bf16* zp = Z1 + ((((size_t)(b * 4 + gq) * 128 + s2) * 128 + cp) * 2 + ri) * 64 + 4 * g;
#pragma unroll
            for (int a = 0; a < 4; ++a) { f32x4 acc = (f32x4){0.f, 0.f, 0.f, 0.f};
#pragma unroll
                for (int kk = 0; kk < 4; ++kk) acc = MFMA16(af[a][kk], bfr[kk], acc);
                u32x2 w; w.x = pk2(acc.x, acc.y); w.y = pk2(acc.z, acc.w); *(u32x2*)(zp + 16 * a) = w; }
        }
    }
}
__device__ __forceinline__ void four1_phase(const bf16* Z1, const bf16* F1t, const float* TW, bf16* T2, int gw, int NGW, int lane) {
    const int qi = lane & 15, g = lane >> 4;
    for (int unit = gw; unit < 4096; unit += NGW) {
        const int b = unit >> 10, gq = (unit >> 8) & 3, cp = (unit >> 1) & 127, hf = unit & 1;
        bf16x8 af[4][4];
#pragma unroll
        for (int a = 0; a < 4; ++a)
#pragma unroll
            for (int kk = 0; kk < 4; ++kk) { const int s2 = 16 * (4 * hf + a) + qi; af[a][kk] = *(const bf16x8*)(Z1 + (((size_t)(b * 4 + gq) * 128 + s2) * 128 + cp) * 128 + 32 * kk + 8 * g); }
#pragma unroll 1
        for (int nt = 0; nt < 4; ++nt) {
            bf16x8 bre[4], bim[4];
#pragma unroll
            for (int kk = 0; kk < 4; ++kk) { bre[kk] = *(const bf16x8*)(F1t + (16 * nt + qi) * 128 + 32 * kk + 8 * g); bim[kk] = *(const bf16x8*)(F1t + (64 + 16 * nt + qi) * 128 + 32 * kk + 8 * g); }
            const int s1p = 16 * nt + qi;
            bf16* tp = T2 + (((size_t)(b * 4 + gq) * 128 + cp) * 64 + s1p) * 256;
#pragma unroll
            for (int a = 0; a < 4; ++a) { f32x4 ar = (f32x4){0.f, 0.f, 0.f, 0.f}, ai = (f32x4){0.f, 0.f, 0.f, 0.f};
#pragma unroll
                for (int kk = 0; kk < 4; ++kk) { ar = MFMA16(af[a][kk], bre[kk], ar); ai = MFMA16(af[a][kk], bim[kk], ai); }
                const int s2b = 16 * (4 * hf + a) + 4 * g;
                const f32x4 t0 = *(const f32x4*)(TW + (size_t)(s1p * 128 + s2b) * 2), t1 = *(const f32x4*)(TW + (size_t)(s1p * 128 + s2b) * 2 + 4);
                const float c_[4] = {t0.x, t0.z, t1.x, t1.z}, s_[4] = {t0.y, t0.w, t1.y, t1.w};
                float re[4], im[4];
#pragma unroll
                for (int e = 0; e < 4; ++e) { re[e] = ar[e] * c_[e] + ai[e] * s_[e]; im[e] = ai[e] * c_[e] - ar[e] * s_[e]; }
                u32x2 w; w.x = pk2(re[0], re[1]); w.y = pk2(re[2], re[3]); *(u32x2*)(tp + s2b) = w;
                w.x = pk2(im[0], im[1]); w.y = pk2(im[2], im[3]); *(u32x2*)(tp + 128 + s2b) = w; }
        }
    }
}
__device__ __forceinline__ void four2_phase(LAS unsigned char* lds, const bf16* T2, const bf16* F2t, bf16* MG, const float* g_f, int G, int bid, int wave, int lane) {
    LAS float* ssq = (LAS float*)(lds + LDS_MISC);
    const int qi = lane & 15, g = lane >> 4, gq = wave >> 1, hf = wave & 1;
    for (int unit = bid; unit < 256; unit += G) {
        const int b = unit >> 6, s1p = unit & 63;
        f32x4 acc[4][8];
#pragma unroll
        for (int a = 0; a < 4; ++a)
#pragma unroll
            for (int nt = 0; nt < 8; ++nt) acc[a][nt] = (f32x4){0.f, 0.f, 0.f, 0.f};
#pragma unroll 1
        for (int kk = 0; kk < 8; ++kk) {
            bf16x8 af[4];
#pragma unroll
            for (int a = 0; a < 4; ++a) { const int cp = 16 * (4 * hf + a) + qi; af[a] = *(const bf16x8*)(T2 + (((size_t)(b * 4 + gq) * 128 + cp) * 64 + s1p) * 256 + 32 * kk + 8 * g); }
#pragma unroll
            for (int nt = 0; nt < 8; ++nt) { const bf16x8 bfr = *(const bf16x8*)(F2t + (16 * nt + qi) * 256 + 32 * kk + 8 * g);
#pragma unroll
                for (int a = 0; a < 4; ++a) acc[a][nt] = MFMA16(af[a], bfr, acc[a][nt]); }
        }
#pragma unroll
        for (int nt = 0; nt < 8; ++nt) { float part = 0.f;
#pragma unroll
            for (int a = 0; a < 4; ++a) part += (acc[a][nt].x * acc[a][nt].x + acc[a][nt].y * acc[a][nt].y) + (acc[a][nt].z * acc[a][nt].z + acc[a][nt].w * acc[a][nt].w);
            part += __shfl_xor(part, 16); part += __shfl_xor(part, 32);
            if (g == 0) ssq[wave * 128 + 16 * nt + qi] = part; }
        __syncthreads();
        float rstd[8];
#pragma unroll
        for (int nt = 0; nt < 8; ++nt) { float tot = 0.f;
#pragma unroll
            for (int w = 0; w < 8; ++w) tot += ssq[w * 128 + 16 * nt + qi];
            rstd[nt] = 1.0f / sqrtf(tot * (1.0f / 512.0f) + RMS_EPS); }
        __syncthreads();
#pragma unroll
        for (int a = 0; a < 4; ++a) { const int c4 = gq * 128 + 16 * (4 * hf + a) + 4 * g; const f32x4 gv = *(const f32x4*)(g_f + c4);
#pragma unroll
            for (int nt = 0; nt < 8; ++nt) { const size_t tok = (size_t)b * SEQ + s1p + 64 * (16 * nt + qi); const f32x4 v = acc[a][nt] * rstd[nt] * gv;
                u32x2 w; w.x = pk2(v.x, v.y); w.y = pk2(v.z, v.w); *(u32x2*)(MG + tok * DM + 512 + c4) = w; } }
    }
}

typedef __attribute__((address_space(1))) unsigned gu32;
constexpr size_t WS_CTL = 1 * MiB, CTL_ZERO_BYTES = 16384;
#define XB_TMO      128
#define XB_XCNT(j)  (256  + 64 * (j))
#define XB_XSUB(j)  (1280 + 64 * (j))
#define XB_XGEN(j)  (2304 + 64 * (j))
#define XB_TOP      3328
#define XB_TOPGEN   3392
#define XCD_BAR_WORDS 3456
#define XB_SPIN_CAP (1u << 18)

__device__ __forceinline__ unsigned xb_ld(unsigned* p)              { return __hip_atomic_load(p, __ATOMIC_RELAXED, __HIP_MEMORY_SCOPE_AGENT); }
__device__ __forceinline__ unsigned xb_add(unsigned* p, unsigned v) { return __hip_atomic_fetch_add(p, v, __ATOMIC_RELAXED, __HIP_MEMORY_SCOPE_AGENT); }
__device__ __forceinline__ unsigned xb_xcc_id() { return (unsigned)__builtin_amdgcn_s_getreg((3 << 11) | 20) & 0xFu; }
#define XB_SPIN(cond, bar) do { unsigned _sp = 0; while (cond) { __builtin_amdgcn_s_sleep(1); \
    if ((++_sp & 255u) == 0u) { if (xb_ld(&(bar)[XB_TMO])) break; if (_sp > XB_SPIN_CAP) { atomicAdd(&(bar)[XB_TMO], 1u); break; } } } } while (0)

struct XcdBarrier {
    unsigned* bar; unsigned x;
    volatile LAS unsigned* st;
};

__device__ __forceinline__ XcdBarrier xcd_barrier_post(unsigned* bar, volatile LAS unsigned* st) {
    XcdBarrier b; b.bar = bar; b.x = xb_xcc_id(); b.st = st;
    if (threadIdx.x == 0) (void)xb_add(&bar[XB_XCNT(b.x)], 1u);
    return b;
}
__device__ __forceinline__ void xcd_barrier_complete(unsigned* bar, unsigned x, unsigned& nloc, unsigned& nx) {
    const unsigned G = gridDim.x * gridDim.y * gridDim.z;
    unsigned sum, cnt, mine, sp = 0u;
    for (;;) {
        sum = 0u; cnt = 0u; mine = 0u;
#pragma unroll
        for (unsigned j = 0; j < 16; ++j) { const unsigned c = xb_ld(&bar[XB_XCNT(j)]); sum += c; cnt += (c > 0u) ? 1u : 0u; mine = (j == x) ? c : mine; }
        if (sum == G) break;
        __builtin_amdgcn_s_sleep(1);
        if ((++sp & 255u) == 0u) { if (xb_ld(&bar[XB_TMO])) break; if (sp > XB_SPIN_CAP) { atomicAdd(&bar[XB_TMO], 1u); break; } }
    }
    nloc = mine > 0u ? mine : 1u; nx = cnt > 0u ? cnt : 1u;
}

__device__ __forceinline__ void xcd_barrier(const XcdBarrier& b) {
    asm volatile("s_waitcnt vmcnt(0)" ::: "memory");
    __syncthreads();
    if (threadIdx.x == 0) {
        unsigned* bar = b.bar;
        __builtin_amdgcn_s_waitcnt(0);
        unsigned nloc = b.st[0], nx = b.st[1];
        if (nloc == 0u) { xcd_barrier_complete(bar, b.x, nloc, nx); b.st[0] = nloc; b.st[1] = nx; }
        const unsigned old = xb_add(&bar[XB_XSUB(b.x)], 1u);
        const unsigned gen = old / nloc;
        if (old + 1u == (gen + 1u) * nloc) {
            __builtin_amdgcn_fence(__ATOMIC_RELEASE, "agent");
            asm volatile("s_waitcnt vmcnt(0)" ::: "memory");
            const unsigned og = xb_add(&bar[XB_TOP], 1u);
            const unsigned tg = og / nx;
            if (og + 1u == (tg + 1u) * nx) xb_add(&bar[XB_TOPGEN], 1u);
            else XB_SPIN(xb_ld(&bar[XB_TOPGEN]) == tg, bar);
            __builtin_amdgcn_fence(__ATOMIC_ACQUIRE, "agent");
            xb_add(&bar[XB_XGEN(b.x)], 1u);
            asm volatile("s_waitcnt vmcnt(0)" ::: "memory");
        } else {
            XB_SPIN(xb_ld(&bar[XB_XGEN(b.x)]) == gen, bar);
            __builtin_amdgcn_fence(__ATOMIC_ACQUIRE, "agent");
            asm volatile("s_waitcnt vmcnt(0)" ::: "memory");
        }
    }
    __syncthreads();
}

struct Args { const float* in[18]; float* out; unsigned char* ws; int ph_lo, ph_hi, single, stop; };

typedef const __attribute__((address_space(4))) Args* KArgs;
__device__ __forceinline__ KArgs kargs() { KArgs p = (KArgs)__builtin_amdgcn_kernarg_segment_ptr(); asm volatile("" : "+s"(p)); return p; }
#define WSP(off) ((bf16*)(A->ws + (off)))

__global__ void __launch_bounds__(NWAVES * 64, 2) fwd_megakernel(Args a_unused) {
    extern __shared__ __attribute__((aligned(16))) unsigned char lds_raw[];
    LAS unsigned char* lds = (LAS unsigned char*)lds_raw;
    const int G = gridDim.x, bid = blockIdx.x;
    int ph = 0; int ph_lo, ph_hi, single, stop;
    { KArgs A = kargs(); ph_lo = A->ph_lo; ph_hi = A->ph_hi; single = A->single; stop = A->stop; }
    volatile LAS unsigned* bst = (volatile LAS unsigned*)(lds + LDS_MISC + 8192);
    if (threadIdx.x < 2) bst[threadIdx.x] = 0u;
    __syncthreads();
    XcdBarrier bar; bar.bar = nullptr; bar.x = 0; bar.st = nullptr;
    if (single) { KArgs A = kargs(); bar = xcd_barrier_post((unsigned*)(A->ws + WS_CTL), bst);
        cg::this_grid().sync(); }
#define RUN (ph >= ph_lo && ph < ph_hi && ph < stop)
#define SEAM() do { if (single) xcd_barrier(bar); ++ph; } while (0)
#define IDS() int tid_ = threadIdx.x; asm volatile("" : "+v"(tid_)); const int tid = tid_, lane = tid & 63, wave = __builtin_amdgcn_readfirstlane(tid >> 6), gw = bid * NWAVES + wave, NGW = G * NWAVES; (void)lane; (void)gw; (void)NGW; (void)tid

    if (RUN) {
        KArgs A = kargs(); IDS();
        bf16* WB = WSP(WS_W); bf16* XB = WSP(WS_XB);
        bf16* F0t = WSP(WS_TAB + TAB_F0); bf16* F1t = WSP(WS_TAB + TAB_F1); bf16* F2t = WSP(WS_TAB + TAB_F2); float* TW = (float*)WSP(WS_TAB + TAB_TW);
        LAS float* scr = (LAS float*)(lds + wave * 16384);
        constexpr int I_G = 16 * 88, I_D = 44 * 32, I_IN = 16 * 64, I_OUT = 16 * 32, I_L = 4 * I_G + 2 * I_D + I_IN + I_OUT;
        for (int it = gw; it < NLAYER * I_L; it += NGW) {
            const int l = it / I_L; int r = it % I_L; bf16* wl = WB + (size_t)l * WL_END;
            if (r < I_G) { p0_transpose_item(A->in[1] + (size_t)l * DM * DFF, DM, DFF, wl + WL_GU1, 1, scr, r, lane); continue; } r -= I_G;
            if (r < I_G) { p0_transpose_item(A->in[2] + (size_t)l * DM * DFF, DM, DFF, wl + WL_GU1, 2, scr, r, lane); continue; } r -= I_G;
            if (r < I_D) { p0_transpose_item(A->in[3] + (size_t)l * DFF * DM, DFF, DM, wl + WL_D1, 0, scr, r, lane); continue; } r -= I_D;
            if (r < I_IN) { p0_transpose_item(A->in[6] + (size_t)l * DM * 2048, DM, 2048, wl + WL_IN, 0, scr, r, lane); continue; } r -= I_IN;
            if (r < I_OUT) { p0_transpose_item(A->in[10] + (size_t)l * DM * DM, DM, DM, wl + WL_OUT, 0, scr, r, lane); continue; } r -= I_OUT;
            if (r < I_G) { p0_transpose_item(A->in[13] + (size_t)l * DM * DFF, DM, DFF, wl + WL_GU2, 1, scr, r, lane); continue; } r -= I_G;
            if (r < I_G) { p0_transpose_item(A->in[14] + (size_t)l * DM * DFF, DM, DFF, wl + WL_GU2, 2, scr, r, lane); continue; } r -= I_G;
            p0_transpose_item(A->in[15] + (size_t)l * DFF * DM, DFF, DM, wl + WL_D2, 0, scr, r, lane);
        }
        const float* xin = A->in[0];
        for (int m = gw; m < MTOK; m += NGW) {
            const f32x4* xr = (const f32x4*)(xin + (size_t)m * DM) + lane; u32x2* ob = (u32x2*)(XB + (size_t)m * DM) + lane;
#pragma unroll
            for (int j = 0; j < 4; ++j) { const f32x4 v = xr[64 * j]; u32x2 w; w.x = pk2(v.x, v.y); w.y = pk2(v.z, v.w); ob[64 * j] = w; }
        }
        for (int i = bid * 512 + tid; i < 32768 + 16384 + 32768 + 8192; i += G * 512) {
            float sn, cs;
            if (i < 32768) { const int n = i >> 7, c = i & 127, ri = n >> 7, cp = n & 127; sincospif((float)((c * cp) & 127) * (1.0f / 64.0f), &sn, &cs); F0t[i] = (bf16)f2bf((ri == 0 ? cs : -sn) * 0.125f); }
            else if (i < 49152) { const int e = i - 32768, n = e >> 7, k = e & 127, rip = n >> 6, s1p = n & 63, ri = k >> 6, s1 = k & 63; sincospif((float)((s1 * s1p) & 63) * (1.0f / 32.0f), &sn, &cs);
                const float v = (rip == ri) ? cs : (rip == 0 ? sn : -sn); F1t[e] = (bf16)f2bf(v * 0.125f); }
            else if (i < 81920) { const int e = i - 49152, s2p = e >> 8, k = e & 255, ri = k >> 7, s2 = k & 127; sincospif((float)((s2 * s2p) & 127) * (1.0f / 64.0f), &sn, &cs); F2t[e] = (bf16)f2bf((ri == 0 ? cs : sn) * 0.0625f); }
            else { const int e = i - 81920, s1p = e >> 7, s2 = e & 127; sincospif((float)(s1p * s2) * (1.0f / 4096.0f), &sn, &cs); TW[2 * e] = cs; TW[2 * e + 1] = sn; }
        }
    }
    SEAM();

#pragma unroll 1
    for (int i = 0; i < 2 * NLAYER; ++i) {
        const int l = i >> 1, f = i & 1;
        if (f == 1) {
            if (RUN) { KArgs A = kargs(); pg8::Gemm gm{WSP(WS_XB), WSP(WS_W) + (size_t)l * WL_END + WL_IN, MTOK, 2048, DM}; pg8::StaticOrder S; S.init(MTOK, 2048, G, bid); EpiProj E{WSP(WS_Q)};
                pg8::gemm_phase<EpiProj, pg8::StaticOrder>(lds, gm, S, E, nullptr); }
            SEAM();
            if (RUN) { KArgs A = kargs(); IDS();
                attn_phase(lds, WSP(WS_Q), WSP(WS_K), WSP(WS_VT), WSP(WS_MG), A->in[7] + (size_t)l * 8 * 465, A->in[8] + (size_t)l * 512, G, bid, wave, lane);
                four0_phase(WSP(WS_U), WSP(WS_TAB + TAB_F0), WSP(WS_Z1), gw, NGW, lane); }
            SEAM();
            if (RUN) { KArgs A = kargs(); IDS(); four1_phase(WSP(WS_Z1), WSP(WS_TAB + TAB_F1), (const float*)WSP(WS_TAB + TAB_TW), WSP(WS_T2), gw, NGW, lane); }
            SEAM();
            if (RUN) { KArgs A = kargs(); IDS(); four2_phase(lds, WSP(WS_T2), WSP(WS_TAB + TAB_F2), WSP(WS_MG), A->in[9] + (size_t)l * 512, G, bid, wave, lane); }
            SEAM();
            if (RUN) { KArgs A = kargs(); pg8::Gemm gm{WSP(WS_MG), WSP(WS_W) + (size_t)l * WL_END + WL_OUT, MTOK, DM, DM}; pg8::StaticOrder S; S.init(MTOK, DM, G, bid); EpiResid E{A->out, A->out, 1.0f};
                pg8::gemm_phase<EpiResid, pg8::StaticOrder>(lds, gm, S, E, nullptr); }
            SEAM();
            if (RUN) { KArgs A = kargs(); IDS(); ln_rows(A->out, A->out, WSP(WS_XB), A->in[11] + (size_t)l * DM, A->in[12] + (size_t)l * DM, gw, NGW, lane); }
            SEAM();
        }
        if (RUN) { KArgs A = kargs(); pg8::Gemm gm{WSP(WS_XB), WSP(WS_W) + (size_t)l * WL_END + (f ? WL_GU2 : WL_GU1), MTOK, 2 * DFF, DM}; pg8::StaticOrder S; S.init(MTOK, 2 * DFF, G, bid); EpiSwiGLU E{WSP(WS_H)};
            pg8::gemm_phase<EpiSwiGLU, pg8::StaticOrder>(lds, gm, S, E, nullptr); }
        SEAM();
        if (RUN) { KArgs A = kargs(); pg8::Gemm gm{WSP(WS_H), WSP(WS_W) + (size_t)l * WL_END + (f ? WL_D2 : WL_D1), MTOK, DM, DFF}; pg8::StaticOrder S; S.init(MTOK, DM, G, bid);
            const float* src = A->out; if (i == 0) src = A->in[0];
            EpiResid E{src, A->out, 0.5f};
            pg8::gemm_phase<EpiResid, pg8::StaticOrder>(lds, gm, S, E, nullptr); }
        SEAM();
        if (RUN) { KArgs A = kargs(); IDS(); const float* gp = f ? A->in[16] : A->in[4]; const float* bp = f ? A->in[17] : A->in[5];
            ln_rows(A->out, A->out, WSP(WS_XB), gp + (size_t)l * DM, bp + (size_t)l * DM, gw, NGW, lane); }
        SEAM();
    }
#if MK_STOP < 25
    if (ph >= ph_lo && ph < ph_hi) {
        KArgs A = kargs(); const unsigned short* w16 = (const unsigned short*)A->ws; float* o = A->out;
        for (size_t i = (size_t)bid * 512 + threadIdx.x; i < (size_t)MTOK * DM; i += (size_t)G * 512) {
            float h = 0.f;
            for (int k = 0; k < 7; ++k) { const size_t j = i + (size_t)k * 33554432u; if (j < WS_END / 2) h += (float)w16[j]; }
            const unsigned b = __builtin_bit_cast(unsigned, o[i]);
            o[i] = h + (float)(b >> 16) + (float)(b & 0xffffu);
        }
    }
#endif
}
constexpr int N_PHASES = 1 + NLAYER * (3 + 6 + 3);

#ifndef MK_MULTI
#define MK_MULTI 0
#endif
extern "C" void kernel_launch(void* const* d_in, const int* in_sizes, int n_in, void* d_out, int out_size, void* d_ws, size_t ws_size, hipStream_t stream) {
    static int grid = 0;
    if (grid == 0) {
        if (n_in != 18 || out_size != MTOK * DM || ws_size < WS_END) { fprintf(stderr, "kernel_launch: unexpected shapes (n_in %d out %d ws %zu)\n", n_in, out_size, ws_size); grid = -1; return; }
        int dev = 0, cus = 0, per_cu = 0;
        (void)hipGetDevice(&dev); (void)hipDeviceGetAttribute(&cus, hipDeviceAttributeMultiprocessorCount, dev);
        if (hipFuncSetAttribute((const void*)fwd_megakernel, hipFuncAttributeMaxDynamicSharedMemorySize, LDS_BYTES) != hipSuccess) { fprintf(stderr, "kernel_launch: hipFuncSetAttribute failed\n"); grid = -1; return; }
        if (hipOccupancyMaxActiveBlocksPerMultiprocessor(&per_cu, (const void*)fwd_megakernel, NWAVES * 64, LDS_BYTES) != hipSuccess || per_cu < 1) { fprintf(stderr, "kernel_launch: occupancy query says %d\n", per_cu); per_cu = 1; }
        (void)hipGetLastError();
        grid = cus;
    }
    if (grid < 0) return;
    if (hipMemsetAsync((char*)d_ws + WS_CTL, 0, CTL_ZERO_BYTES, stream) != hipSuccess) { fprintf(stderr, "kernel_launch: memset failed\n"); return; }
    Args a{};
    for (int i = 0; i < 18; ++i) a.in[i] = (const float*)d_in[i];
    a.out = (float*)d_out; a.ws = (unsigned char*)d_ws;
#if MK_MULTI
    a.stop = MK_STOP;
    for (int p = 0; p < N_PHASES + (MK_STOP < 25 ? 1 : 0); ++p) { a.ph_lo = p; a.ph_hi = p + 1; a.single = 0; hipLaunchKernelGGL(fwd_megakernel, dim3(grid), dim3(NWAVES * 64), LDS_BYTES, stream, a); }
#else
    a.ph_lo = 0; a.ph_hi = N_PHASES + 1; a.single = 1; a.stop = MK_STOP;
    void* args[] = {&a};
    hipError_t e = hipLaunchCooperativeKernel((const void*)fwd_megakernel, dim3(grid), dim3(NWAVES * 64), args, LDS_BYTES, stream);
    if (e != hipSuccess) fprintf(stderr, "kernel_launch: cooperative launch failed: %s (grid %d)\n", hipGetErrorString(e), grid);
#endif
}
```

```cpp
#include <hip/hip_cooperative_groups.h>
#include <cstdio>
#include <cstdint>
namespace pg8 {
#define PG8_LAS __attribute__((address_space(3)))
typedef unsigned short bf16_t;
typedef short bf16x8 __attribute__((ext_vector_type(8)));
typedef float f32x4 __attribute__((ext_vector_type(4)));
typedef unsigned u32x4 __attribute__((ext_vector_type(4)));
constexpr int BM = 256, BK = 64, HALF = 128, HTB = HALF * BK * 2  , STAGE_BYTES = 8 * HTB, NXCD = 8, WGM = 8;

__host__ __device__ __forceinline__ int lds_byte(int r, int c) { const int st = (r >> 4) * 2 + (c >> 5), rr = r & 15, cc = c & 31, ob = rr * 64 + cc * 2; return st * 1024 + (ob ^ (((ob >> 9) & 1) << 5)); }
__host__ __device__ __forceinline__ void stage_rc(int b, int& R, int& C) { const int st = b / 1024, sb = b % 1024, swz = sb ^ (((sb >> 9) & 1) << 5); R = (st >> 1) * 16 + swz / 64; C = (st & 1) * 32 + (swz % 64) / 2; }
__host__ __device__ __forceinline__ int perm32(int rho) { const int n = rho >> 4, i = rho & 15; return 8 * (i >> 2) + 4 * n + (i & 3); }

struct Unit { int pm, pn; };
struct Gemm { const bf16_t* A; const bf16_t* Bt; int M, N, K; };

struct StaticOrder {
    int nM, nN, nwg, G, c;
    __host__ __device__ void init(int M, int N, int G_, int c_) { nM = M / BM; nN = N / BM; nwg = nM * nN; G = G_; c = c_; }
    __host__ __device__ bool next(int i, Unit& u) const {
        const long L = (long)i * G + c; if (L >= nwg) return false;
        int wgid = (int)L; { const int q = nwg / NXCD, r = nwg % NXCD, xcd = wgid % NXCD, off = wgid / NXCD; wgid = (xcd < r ? xcd * (q + 1) : r * (q + 1) + (xcd - r) * q) + off; }
        const int nig = WGM * nN, gid = wgid / nig, fm = gid * WGM, gsz = (nM - fm) < WGM ? (nM - fm) : WGM;
        u.pm = fm + ((wgid % nig) % gsz); u.pn = (wgid % nig) / gsz; return true;
    }
    __device__ __forceinline__ void a_ready(const Unit&) const {}
    __device__ __forceinline__ void done(const Unit&) const {}
};
__device__ __forceinline__ unsigned cvt_pk_bf16(float lo, float hi) { unsigned r; asm volatile("v_cvt_pk_bf16_f32 %0, %1, %2" : "=v"(r) : "v"(lo), "v"(hi)); return r; }
typedef float f32x2 __attribute__((ext_vector_type(2)));
template <class Epi, class Sched, bool STAMP = false>
__device__ __forceinline__ void gemm_phase(PG8_LAS unsigned char* lds, const Gemm g, const Sched& S, const Epi& E, unsigned long long* stamps) {
    int tid_ = threadIdx.x; asm volatile("" : "+v"(tid_));
    const int tid = tid_, wid = __builtin_amdgcn_readfirstlane(tid >> 6), lane = tid & 63, wr = wid >> 2, wc = wid & 3, fr = lane & 15, fq = lane >> 4;
    const int K = g.K, nt = K / BK;
    int ts_lo = 0, ts_hi = 0, nts = 0; const unsigned long long rt_entry = STAMP ? (unsigned long long)wall_clock64() : 0ull;
#define PG8_STAMP() do { if (STAMP && wid == 0 && nts < 64) { const unsigned long long _c = (unsigned long long)clock64(); \
        ts_lo = (lane == nts) ? (int)(unsigned)_c : ts_lo; ts_hi = (lane == nts) ? (int)(unsigned)(_c >> 32) : ts_hi; ++nts; } } while (0)
    PG8_STAMP();
    unsigned voffA[2], voffB[2];
#pragma unroll
    for (int i = 0; i < 2; ++i) { int R, C; stage_rc(tid * 16 + i * 8192, R, C); const int Rb = Epi::PERM ? ((R & ~31) + perm32(R & 31)) : R;
        voffA[i] = (unsigned)(R * K + C) * 2u; voffB[i] = (unsigned)(Rb * K + C) * 2u; }
    const size_t kstep = (size_t)(BK * 2);
    const size_t hstep = (size_t)HALF * K * 2;
    const size_t tstep = 2 * hstep;
    const unsigned ldsw = (unsigned)wid * 1024u;
    const int aoff = lds_byte(wr * 64 + fr, fq * 8), boff = lds_byte(wc * 32 + fr, fq * 8);
#define PG8_SA(b, h) (((b) * 2 + (h)) * HTB)
#define PG8_SB(b, h) ((4 + (b) * 2 + (h)) * HTB)
#define PG8_STAGE(bufoff, gbase, voff) do { _Pragma("unroll") for (int _i = 0; _i < 2; ++_i) \
        __builtin_amdgcn_global_load_lds((const unsigned*)((const char*)(gbase) + (voff)[_i]), (PG8_LAS unsigned*)(lds + (bufoff) + ldsw + _i * 8192), 16, 0, 0); } while (0)
#define PG8_LDA(dst, b, h) do { _Pragma("unroll") for (int m = 0; m < 4; ++m) _Pragma("unroll") for (int k = 0; k < 2; ++k) dst[m][k] = *(const PG8_LAS bf16x8*)(lds + PG8_SA(b, h) + aoff + m * 2048 + k * 1024); } while (0)
#define PG8_LDB(dst, b, h) do { _Pragma("unroll") for (int n = 0; n < 2; ++n) _Pragma("unroll") for (int k = 0; k < 2; ++k) dst[n][k] = *(const PG8_LAS bf16x8*)(lds + PG8_SB(b, h) + boff + n * 2048 + k * 1024); } while (0)
#define PG8_MMA(ai, bj, At, Bt) do { __builtin_amdgcn_s_setprio(1); _Pragma("unroll") for (int m = 0; m < 4; ++m) _Pragma("unroll") for (int n = 0; n < 2; ++n) _Pragma("unroll") for (int k = 0; k < 2; ++k) \
        acc[ai][bj][m][n] = __builtin_amdgcn_mfma_f32_16x16x32_bf16(Bt[n][k], At[m][k], acc[ai][bj][m][n], 0, 0, 0); __builtin_amdgcn_s_setprio(0); } while (0)
#define PG8_WAIT_V(n) asm volatile("s_waitcnt vmcnt(" #n ")" ::: "memory")
#define PG8_WAIT_L(n) asm volatile("s_waitcnt lgkmcnt(" #n ")" ::: "memory")
#define PG8_BAR __builtin_amdgcn_s_barrier()
#define PG8_SCHED __builtin_amdgcn_sched_barrier(0)
    Unit cur, nxt; int ui = 0;
    if (!S.next(0, cur)) return;
    f32x4 acc[2][2][4][2];
#pragma unroll
    for (int a = 0; a < 2; ++a)
#pragma unroll
        for (int b = 0; b < 2; ++b)
#pragma unroll
            for (int m = 0; m < 4; ++m)
#pragma unroll
                for (int n = 0; n < 2; ++n) acc[a][b][m][n] = (f32x4){0.f, 0.f, 0.f, 0.f};
    bf16x8 At[4][2], B0[2][2], B1[2][2];
    const char* cA = (const char*)g.A + (size_t)cur.pm * tstep; const char* cB = (const char*)g.Bt + (size_t)cur.pn * tstep;
    S.a_ready(cur);
    PG8_STAGE(PG8_SB(0, 0), cB, voffB); PG8_STAGE(PG8_SA(0, 0), cA, voffA); PG8_STAGE(PG8_SB(0, 1), cB + hstep, voffB); PG8_STAGE(PG8_SA(0, 1), cA + hstep, voffA);
    if (wr == 1) PG8_BAR;
    PG8_WAIT_V(4); PG8_BAR;
    PG8_STAGE(PG8_SB(1, 0), cB + kstep, voffB); PG8_STAGE(PG8_SA(1, 0), cA + kstep, voffA); PG8_STAGE(PG8_SB(1, 1), cB + hstep + kstep, voffB);
    PG8_WAIT_V(6); PG8_BAR;
    PG8_STAMP();
    for (;;) {
        const bool has_next = S.next(ui + 1, nxt);
        const char* nA = has_next ? (const char*)g.A + (size_t)nxt.pm * tstep : cA; const char* nB = has_next ? (const char*)g.Bt + (size_t)nxt.pn * tstep : cB;
        for (int t = 0; t < nt; t += 2) {
            const bool last = (t == nt - 2);
            const char* a1 = cA + (size_t)(t + 1) * kstep;
            const char* a2 = last ? nA : cA + (size_t)(t + 2) * kstep; const char* b2 = last ? nB : cB + (size_t)(t + 2) * kstep;
            const char* a3 = a2 + kstep; const char* b3 = b2 + kstep;
            if (last && has_next) S.a_ready(nxt);
            PG8_LDB(B0, 0, 0); PG8_SCHED; PG8_LDA(At, 0, 0); PG8_STAGE(PG8_SA(1, 1), a1 + hstep, voffA);
            PG8_WAIT_L(8); PG8_BAR; PG8_WAIT_L(0); PG8_MMA(0, 0, At, B0); PG8_BAR; PG8_SCHED;
            PG8_LDB(B1, 0, 1); PG8_STAGE(PG8_SB(0, 0), b2, voffB);
            PG8_BAR; PG8_WAIT_L(0); PG8_MMA(0, 1, At, B1); PG8_BAR;
            PG8_LDA(At, 0, 1); PG8_STAGE(PG8_SA(0, 0), a2, voffA);
            PG8_BAR; PG8_WAIT_L(0); PG8_MMA(1, 0, At, B0); PG8_BAR; PG8_SCHED;
            PG8_STAGE(PG8_SB(0, 1), b2 + hstep, voffB);
            PG8_WAIT_V(6); PG8_BAR; PG8_MMA(1, 1, At, B1); PG8_BAR;
            PG8_LDB(B0, 1, 0); PG8_SCHED; PG8_LDA(At, 1, 0); PG8_STAGE(PG8_SA(0, 1), a2 + hstep, voffA);
            PG8_WAIT_L(8); PG8_BAR; PG8_WAIT_L(0); PG8_MMA(0, 0, At, B0); PG8_BAR; PG8_SCHED;
            PG8_LDB(B1, 1, 1); PG8_STAGE(PG8_SB(1, 0), b3, voffB);
            PG8_BAR; PG8_WAIT_L(0); PG8_MMA(0, 1, At, B1); PG8_BAR;
            PG8_LDA(At, 1, 1); PG8_STAGE(PG8_SA(1, 0), a3, voffA);
            PG8_BAR; PG8_WAIT_L(0); PG8_MMA(1, 0, At, B0); PG8_BAR; PG8_SCHED;
            PG8_STAGE(PG8_SB(1, 1), b3 + hstep, voffB);
            PG8_WAIT_V(6); PG8_BAR; PG8_MMA(1, 1, At, B1); PG8_BAR;
        }
        PG8_STAMP();
        if constexpr (!Epi::AFTER_DRAIN) { E(acc, cur, wr, wc, fr, fq); S.done(cur); }
        PG8_STAMP();
        if (!has_next) break;
#pragma unroll
        for (int a = 0; a < 2; ++a)
#pragma unroll
            for (int b = 0; b < 2; ++b)
#pragma unroll
                for (int m = 0; m < 4; ++m)
#pragma unroll
                    for (int n = 0; n < 2; ++n) acc[a][b][m][n] = (f32x4){0.f, 0.f, 0.f, 0.f};
        cur = nxt; cA = nA; cB = nB; ++ui;
    }
    PG8_WAIT_V(0);
    if (wr == 0) PG8_BAR;
    PG8_BAR;
    if constexpr (Epi::AFTER_DRAIN) { E.fused(acc, cur, wr, wc, fr, fq, lds, wid, lane); S.done(cur); }
    PG8_STAMP();
    if (STAMP && wid == 0) { stamps[lane] = lane < nts ? (((unsigned long long)(unsigned)ts_hi << 32) | (unsigned)ts_lo) : 0ull;
        if (lane == 62) stamps[62] = rt_entry; if (lane == 63) stamps[63] = (unsigned long long)wall_clock64(); }
#undef PG8_STAMP
#undef PG8_SA
#undef PG8_SB
#undef PG8_STAGE
#undef PG8_LDA
#undef PG8_LDB
#undef PG8_MMA
#undef PG8_WAIT_V
#undef PG8_WAIT_L
#undef PG8_BAR
#undef PG8_SCHED
}
}

namespace cg = cooperative_groups;
#define MK_REP_ATTN 1
#define MK_REP_F0 1
#define MK_REP_F1 1
#define MK_REP_F2 1
#ifndef MK_PROF_A
#define MK_PROF_A -1
#define MK_PROF_B -1
#endif
#ifndef MK_STOP
#define MK_STOP 25
#endif

#define LAS __attribute__((address_space(3)))
typedef unsigned short bf16;
typedef float f32x4 __attribute__((ext_vector_type(4)));
typedef float f32x2 __attribute__((ext_vector_type(2)));
typedef short bf16x8 __attribute__((ext_vector_type(8)));
typedef unsigned u32x4 __attribute__((ext_vector_type(4)));
typedef unsigned u32x2 __attribute__((ext_vector_type(2)));

constexpr int NWAVES = 8;
constexpr int MTOK = 32768, DM = 1024, DFF = 2816, SEQ = 8192, NLAYER = 2;
constexpr float ALPHA = 1.41421356237309515f;
constexpr float LN_EPS = 1e-5f, RMS_EPS = 1e-6f;
constexpr int LDS_BYTES = 147456;
constexpr int LDS_MISC = 131072;

constexpr size_t MiB = 1u << 20;
constexpr size_t WS_TAB = 0;
constexpr size_t TAB_F0 = 0, TAB_F1 = 65536, TAB_F2 = 98304, TAB_TW = 163840;
constexpr size_t WS_W = 2 * MiB;
constexpr size_t W_GU = (size_t)5632 * 1024, W_D = (size_t)1024 * 2816, W_IN = (size_t)2048 * 1024, W_OUT = (size_t)1024 * 1024;
constexpr size_t WL_GU1 = 0, WL_D1 = WL_GU1 + W_GU, WL_IN = WL_D1 + W_D, WL_OUT = WL_IN + W_IN, WL_GU2 = WL_OUT + W_OUT, WL_D2 = WL_GU2 + W_GU, WL_END = WL_D2 + W_D;
static_assert(WS_W + 2 * WL_END * 2 <= 82 * MiB, "weights");
constexpr size_t WS_XB = 82 * MiB;
constexpr size_t WS_MG = 146 * MiB;
constexpr size_t WS_H = 210 * MiB;
constexpr size_t WS_Q = 210 * MiB, WS_K = 242 * MiB, WS_VT = 274 * MiB, WS_U = 306 * MiB, WS_Z1 = 338 * MiB, WS_T2 = 210 * MiB;
constexpr size_t WS_END = 402 * MiB;

__device__ __forceinline__ unsigned f2bf(float f) { unsigned u = __builtin_bit_cast(unsigned, f); return (u + 0x7fffu + ((u >> 16) & 1u)) >> 16; }
typedef __bf16 bf16v2 __attribute__((ext_vector_type(2)));
__device__ __forceinline__ unsigned pk2(float lo, float hi) { const f32x2 v = {lo, hi}; const bf16v2 b = __builtin_convertvector(v, bf16v2); return __builtin_bit_cast(unsigned, b); }
#define LDS_WAIT() asm volatile("s_waitcnt lgkmcnt(0)" ::: "memory")

struct EpiSwiGLU {
    static constexpr bool PERM = true, AFTER_DRAIN = false;
    bf16* H;
    __device__ __forceinline__ void operator()(const pg8::f32x4 (&acc)[2][2][4][2], const pg8::Unit& u, int wr, int wc, int fr, int fq) const {
        const int row0 = u.pm * 256 + wr * 64 + fr, col0 = u.pn * 128 + wc * 32 + 8 * fq;
#pragma unroll
        for (int ai = 0; ai < 2; ++ai)
#pragma unroll
            for (int m = 0; m < 4; ++m) {
                bf16* rowp = H + (size_t)(row0 + ai * 128 + m * 16) * DFF + col0;
                float hv[8];
#pragma unroll
                for (int n = 0; n < 2; ++n)
#pragma unroll
                    for (int e = 0; e < 4; ++e) { const float g = acc[ai][0][m][n][e], up = acc[ai][1][m][n][e];
                        const float sg = g * __builtin_amdgcn_rcpf(1.0f + __builtin_amdgcn_exp2f(g * -1.44269504089f)); hv[n * 4 + e] = sg * up; }
                u32x4 w; w.x = pk2(hv[0], hv[1]); w.y = pk2(hv[2], hv[3]); w.z = pk2(hv[4], hv[5]); w.w = pk2(hv[6], hv[7]);
                *(u32x4*)rowp = w;
            }
    }
};
struct EpiResid {
    static constexpr bool PERM = false, AFTER_DRAIN = false;
    const float* src; float* dst; float scale;
    __device__ __forceinline__ void operator()(const pg8::f32x4 (&acc)[2][2][4][2], const pg8::Unit& u, int wr, int wc, int fr, int fq) const {
        const int row0 = u.pm * 256 + wr * 64 + fr, col0 = u.pn * 256 + wc * 32 + 4 * fq;
#pragma unroll
        for (int ai = 0; ai < 2; ++ai)
#pragma unroll
            for (int m = 0; m < 4; ++m) { const size_t off = (size_t)(row0 + ai * 128 + m * 16) * DM + col0;
#pragma unroll
                for (int bj = 0; bj < 2; ++bj)
#pragma unroll
                    for (int n = 0; n < 2; ++n) { const f32x4 s = *(const f32x4*)(src + off + bj * 128 + n * 16); const f32x4 o = s * ALPHA + acc[ai][bj][m][n] * scale; *(f32x4*)(dst + off + bj * 128 + n * 16) = o; }
                asm volatile("" ::: "memory"); }
    }
};
struct EpiProj {
    static constexpr bool PERM = true, AFTER_DRAIN = false;
    bf16* P;
    __device__ __forceinline__ void operator()(const pg8::f32x4 (&acc)[2][2][4][2], const pg8::Unit& u, int wr, int wc, int fr, int fq) const {
        const int t = u.pn >> 1; const int row0 = u.pm * 256 + wr * 64 + fr, cl = (u.pn & 1) * 256 + wc * 32 + 8 * fq;
        bf16* base = P + (size_t)t * (16u << 20);
        if (t != 2) {
            const float sc = (t == 0) ? 0.125f : 1.0f;
#pragma unroll
            for (int ai = 0; ai < 2; ++ai)
#pragma unroll
                for (int m = 0; m < 4; ++m) { const int row = row0 + ai * 128 + m * 16; const int b = row >> 13, s = row & 8191;
#pragma unroll
                    for (int bj = 0; bj < 2; ++bj) { const int c8 = cl + bj * 128;
                        const int col = s & 63, d0 = c8 & 63;
                        const size_t off = (t == 3) ? (((((size_t)(b * 4 + (c8 >> 7)) * 128 + (s & 127)) * 64 + (s >> 7)) * 128) + (c8 & 127))
                                         : (t == 0) ? ((((size_t)(b * 8 + (c8 >> 6)) * SEQ + s) * 64) + d0)
                                         : (((((size_t)(b * 8 + (c8 >> 6)) * 128 + (s >> 6)) * 8 + (col >> 5) * 4 + ((col >> 2) & 1) * 2 + (d0 >> 5)) * 64 + ((d0 >> 3) & 3) * 16 + ((col >> 3) & 3) * 4 + (col & 3)) * 8);
                        const f32x4 v0 = acc[ai][bj][m][0] * sc, v1 = acc[ai][bj][m][1] * sc;
                        u32x4 w; w.x = pk2(v0[0], v0[1]); w.y = pk2(v0[2], v0[3]); w.z = pk2(v1[0], v1[1]); w.w = pk2(v1[2], v1[3]);
                        *(u32x4*)(base + off) = w; } }
        } else {
#pragma unroll
            for (int ai = 0; ai < 2; ++ai)
#pragma unroll
                for (int m = 0; m < 4; ++m) { const int row = row0 + ai * 128 + m * 16; const int b = row >> 13, s = row & 8191;
#pragma unroll
                    for (int bj = 0; bj < 2; ++bj) { const int c8 = cl + bj * 128;
                        const int col = s & 63, d0 = c8 & 63;
                        bf16* vp = base + (((((size_t)(b * 8 + (c8 >> 6)) * 128 + (s >> 6)) * 8 + (col >> 5) * 4 + (d0 >> 4)) * 64 + ((col >> 3) & 3) * 16 + (d0 & 15)) * 8) + (col & 7);
#pragma unroll
                        for (int n = 0; n < 2; ++n)
#pragma unroll
                            for (int e = 0; e < 4; ++e) vp[(n * 4 + e) * 8] = (bf16)f2bf(acc[ai][bj][m][n][e]); } }
        }
    }
};

__device__ __forceinline__ float wave_sum(float v) {
#pragma unroll
    for (int o = 1; o < 64; o <<= 1) v += __shfl_xor(v, o);
    return v;
}
__device__ __forceinline__ void p0_transpose_item(const float* W, int K, int N, bf16* WT, int mode, LAS float* scr, int item, int lane) {
    const int nblk = N / 32, kb = item / nblk, nb = item % nblk, k0 = 64 * kb, n0 = 32 * nb;
    const int r0 = (mode == 0) ? n0 : (256 * (n0 >> 7) + (n0 & 127) + (mode == 2 ? 128 : 0));
#pragma unroll 8
    for (int i = 0; i < 32; ++i) { const int kk = 2 * i + (lane >> 5); scr[kk * 33 + (lane & 31)] = W[(size_t)(k0 + kk) * N + n0 + (lane & 31)]; }
    LDS_WAIT(); asm volatile("" ::: "memory");
    const int c = lane & 7;
#pragma unroll
    for (int j = 0; j < 4; ++j) { const int n = (lane >> 3) + 8 * j; const LAS float* s = scr + (8 * c) * 33 + n;
        u32x4 o; o.x = pk2(s[0 * 33], s[1 * 33]); o.y = pk2(s[2 * 33], s[3 * 33]); o.z = pk2(s[4 * 33], s[5 * 33]); o.w = pk2(s[6 * 33], s[7 * 33]);
        *(u32x4*)(WT + (size_t)(r0 + n) * K + k0 + 8 * c) = o; }
    LDS_WAIT(); asm volatile("" ::: "memory");
}
__device__ __forceinline__ void ln_rows(const float* Y, float* XF, bf16* XB, const float* g, const float* b, int gw, int NGW, int lane) {
    for (int m = gw; m < MTOK; m += NGW) {
        const f32x4* xr = (const f32x4*)(Y + (size_t)m * DM) + lane;
        f32x4 v[4]; float s = 0.f;
#pragma unroll
        for (int j = 0; j < 4; ++j) { v[j] = xr[64 * j]; s += (v[j].x + v[j].y) + (v[j].z + v[j].w); }
        const float mean = wave_sum(s) * (1.f / DM); float s2 = 0.f;
#pragma unroll
        for (int j = 0; j < 4; ++j) { v[j] = v[j] - mean; s2 += (v[j].x * v[j].x + v[j].y * v[j].y) + (v[j].z * v[j].z + v[j].w * v[j].w); }
        const float rstd = 1.f / sqrtf(wave_sum(s2) * (1.f / DM) + LN_EPS);
        f32x4* of = (f32x4*)(XF + (size_t)m * DM) + lane; u32x2* ob = (u32x2*)(XB + (size_t)m * DM) + lane;
#pragma unroll
        for (int j = 0; j < 4; ++j) { const f32x4 gv = ((const f32x4*)g)[lane + 64 * j], bv = ((const f32x4*)b)[lane + 64 * j]; const f32x4 o = v[j] * rstd * gv + bv;
            of[64 * j] = o; u32x2 w; w.x = pk2(o.x, o.y); w.y = pk2(o.z, o.w); ob[64 * j] = w; }
    }
}

#define MFMA16(a, b, c) __builtin_amdgcn_mfma_f32_16x16x32_bf16((a), (b), (c), 0, 0, 0)

#define SCHED_FENCE() __builtin_amdgcn_sched_barrier(0)
__device__ __forceinline__ void attn_phase(LAS unsigned char* lds, const bf16* Q, const bf16* K, const bf16* VT, bf16* MG, const float* rpb, const float* g_attn, int G, int bid, int wave, int lane) {
    LAS float* rp = (LAS float*)(lds + wave * 16384) + 64;
    LAS float* ssq = (LAS float*)(lds + LDS_MISC);
    const int h = wave, qi = lane & 15, g = lane >> 4;
    for (int i = lane; i < 465; i += 64) rp[i] = rpb[h * 465 + i];
    LDS_WAIT(); asm volatile("" ::: "memory");
    int par = 0;
    const int vcu = (G % 8 == 0) ? (bid % 8) * (G / 8) + bid / 8 : bid;
    for (int unit = vcu; unit < 512; unit += G) {
        const int b = unit >> 7, r = unit & 127;
        const int r0 = min(max(r - 4, 0), 120);
        const bf16* kfr = K + ((size_t)((b * 8 + h) * 128 + r0) * 8) * 512 + lane * 8;
        const bf16* vfr = VT + ((size_t)((b * 8 + h) * 128 + r0) * 8) * 512 + lane * 8;
        LAS bf16x8* qlds = (LAS bf16x8*)(lds + wave * 16384 + 4096) + lane;
#pragma unroll
        for (int j = 0; j < 4; ++j)
#pragma unroll
            for (int kk = 0; kk < 2; ++kk) qlds[(j * 2 + kk) * 64] = *(const bf16x8*)(Q + (((size_t)(b * 8 + h) * SEQ) + 64 * r + 16 * j + qi) * 64 + 32 * kk + 8 * g);
        f32x4 o[4][4]; float mrun[4], lrun[4];
#pragma unroll
        for (int j = 0; j < 4; ++j) { mrun[j] = -3.0e38f; lrun[j] = 0.f;
#pragma unroll
            for (int dt = 0; dt < 4; ++dt) o[j][dt] = (f32x4){0.f, 0.f, 0.f, 0.f}; }
        bf16x8 kf[8], vf[8];
#pragma unroll
        for (int i = 0; i < 8; ++i) kf[i] = *(const bf16x8*)(kfr + i * 512);
#pragma unroll
        for (int i = 0; i < 8; ++i) vf[i] = *(const bf16x8*)(vfr + i * 512);
#pragma unroll 1
        for (int n = 0; n < 8; ++n) {
            f32x4 sc[6][2];
#pragma unroll
            for (int c = 0; c < 6; ++c) { const int j = (c + 1) >> 1, X = (c == 0 || c == 1 || c == 3) ? 0 : 1;
                const bf16x8 q0 = qlds[(j * 2) * 64], q1 = qlds[(j * 2 + 1) * 64];
#pragma unroll
                for (int t = 0; t < 2; ++t) { f32x4 a = (f32x4){0.f, 0.f, 0.f, 0.f}; a = MFMA16(kf[X * 4 + t * 2], q0, a); a = MFMA16(kf[X * 4 + t * 2 + 1], q1, a); sc[c][t] = a; } }
            SCHED_FENCE();
            if (n < 7) {
#pragma unroll
                for (int i = 0; i < 8; ++i) kf[i] = *(const bf16x8*)(kfr + (n + 1) * 4096 + i * 512);
            }
            SCHED_FENCE();
#pragma unroll
            for (int j = 0; j < 4; ++j) {
                const int qc = 16 * j + qi; int c0 = min(max(qc - 8, 0), 48); asm volatile("" : "+v"(c0));
                const int cA = (j == 0) ? 0 : 2 * j - 1, nX = (j == 0 || j == 3) ? 1 : 2, X0 = (j == 3) ? 1 : 0;
                float mx = -3.0e38f; bf16x8 pf[2];
#pragma unroll
                for (int x = 0; x < nX; ++x) { const int X = X0 + x;
                    const LAS float* rq = rp + (r0 - r + 7 + n) * 31 + (32 * X + 8 * g - qc + 15);
#pragma unroll
                    for (int t = 0; t < 2; ++t)
#pragma unroll
                        for (int e = 0; e < 4; ++e) {
                            const int kc = 32 * X + 8 * g + 4 * t + e; const bool inw = (unsigned)(kc - c0) < 16u;
                            float bias = rq[4 * t + e]; asm volatile("" : "+v"(bias));
                            const float sv = inw ? (sc[cA + x][t][e] + bias) : -1.0e30f;
                            sc[cA + x][t][e] = sv; mx = fmaxf(mx, sv);
                        } }
                mx = fmaxf(mx, __shfl_xor(mx, 16)); mx = fmaxf(mx, __shfl_xor(mx, 32));
                const float mnew = fmaxf(mrun[j], mx), alpha = __builtin_amdgcn_exp2f((mrun[j] - mnew) * 1.44269504089f);
                mrun[j] = mnew; float ps = 0.f;
#pragma unroll
                for (int x = 0; x < nX; ++x) {
#pragma unroll
                    for (int t = 0; t < 2; ++t)
#pragma unroll
                        for (int e = 0; e < 4; ++e) { const float pv = __builtin_amdgcn_exp2f((sc[cA + x][t][e] - mnew) * 1.44269504089f); sc[cA + x][t][e] = pv; ps += pv; }
                    u32x4 pw; pw.x = pk2(sc[cA + x][0][0], sc[cA + x][0][1]); pw.y = pk2(sc[cA + x][0][2], sc[cA + x][0][3]); pw.z = pk2(sc[cA + x][1][0], sc[cA + x][1][1]); pw.w = pk2(sc[cA + x][1][2], sc[cA + x][1][3]);
                    pf[x] = __builtin_bit_cast(bf16x8, pw); }
                lrun[j] = lrun[j] * alpha + ps;
#pragma unroll
                for (int dt = 0; dt < 4; ++dt) o[j][dt] = o[j][dt] * alpha;
#pragma unroll
                for (int x = 0; x < nX; ++x)
#pragma unroll
                    for (int dt = 0; dt < 4; ++dt) o[j][dt] = MFMA16(vf[(X0 + x) * 4 + dt], pf[x], o[j][dt]);
            }
            SCHED_FENCE();
            if (n < 7) {
#pragma unroll
                for (int i = 0; i < 8; ++i) vf[i] = *(const bf16x8*)(vfr + (n + 1) * 4096 + i * 512);
            }
            SCHED_FENCE();
        }
#pragma unroll
        for (int j = 0; j < 4; ++j) { float l = lrun[j]; l += __shfl_xor(l, 16); l += __shfl_xor(l, 32); const float inv = 1.0f / l; float part = 0.f;
#pragma unroll
            for (int dt = 0; dt < 4; ++dt) { o[j][dt] = o[j][dt] * inv; part += (o[j][dt].x * o[j][dt].x + o[j][dt].y * o[j][dt].y) + (o[j][dt].z * o[j][dt].z + o[j][dt].w * o[j][dt].w); }
            part += __shfl_xor(part, 16); part += __shfl_xor(part, 32);
            if (g == 0) ssq[par * 512 + h * 64 + 16 * j + qi] = part; }
        __syncthreads();
#pragma unroll
        for (int j = 0; j < 4; ++j) { float tot = 0.f;
#pragma unroll
            for (int hh = 0; hh < 8; ++hh) tot += ssq[par * 512 + hh * 64 + 16 * j + qi];
            const float rstd = 1.0f / sqrtf(tot * (1.0f / 512.0f) + RMS_EPS);
            const size_t qtok = (size_t)b * SEQ + 64 * r + 16 * j + qi;
#pragma unroll
            for (int dt = 0; dt < 4; ++dt) { const f32x4 gv = *(const f32x4*)(g_attn + h * 64 + 16 * dt + 4 * g); const f32x4 v = o[j][dt] * rstd * gv;
                u32x2 w; w.x = pk2(v.x, v.y); w.y = pk2(v.z, v.w); *(u32x2*)(MG + qtok * DM + h * 64 + 16 * dt + 4 * g) = w; } }
        par ^= 1;
    }
    __syncthreads();
}

__device__ __forceinline__ void four0_phase(const bf16* U, const bf16* F0t, bf16* Z1, int gw, int NGW, int lane) {
    const int qi = lane & 15, g = lane >> 4;
    for (int unit = gw; unit < 2048; unit += NGW) {
        const int b = unit >> 9, gq = (unit >> 7) & 3, s2 = unit & 127;
        bf16x8 af[4][4];
#pragma unroll
        for (int a = 0; a < 4; ++a)
#pragma unroll
            for (int kk = 0; kk < 4; ++kk) af[a][kk] = *(const bf16x8*)(U + ((((size_t)(b * 4 + gq) * 128 + s2) * 64 + 16 * a + qi) * 128) + 32 * kk + 8 * g);
#pragma unroll 2
        for (int nt = 0; nt < 16; ++nt) {
            bf16x8 bfr[4];
#pragma unroll
            for (int kk = 0; kk < 4; ++kk) bfr[kk] = *(const bf16x8*)(F0t + (16 * nt + qi) * 128 + 32 * kk + 8 * g);
            const int n = 16 * nt + qi, ri = n >> 7, cp = n & 127;
            bf16* zp = Z1 + ((((size_t)(b * 4 + gq) * 128 + cp) * 128 + s2) * 2 + ri) * 64 + 4 * g;
#pragma unroll
            for (int a = 0; a < 4; ++a) { f32x4 acc = (f32x4){0.f, 0.f, 0.f, 0.f};
#pragma unroll
                for (int kk = 0; kk < 4; ++kk) acc = MFMA16(af[a][kk], bfr[kk], acc);
                u32x2 w; w.x = pk2(acc.x, acc.y); w.y = pk2(acc.z, acc.w); *(u32x2*)(zp + 16 * a) = w; }
        }
    }
}
__device__ __forceinline__ void four1_phase(const bf16* Z1, const bf16* F1t, const float* TW, bf16* T2, int gw, int NGW, int lane) {
    const int qi = lane & 15, g = lane >> 4;
    for (int unit = gw; unit < 4096; unit += NGW) {
        const int b = unit >> 10, gq = (unit >> 8) & 3, cp = (unit >> 1) & 127, hf = unit & 1;
        bf16x8 af[4][4];
#pragma unroll
        for (int a = 0; a < 4; ++a)
#pragma unroll
            for (int kk = 0; kk < 4; ++kk) { const int s2 = 16 * (4 * hf + a) + qi; af[a][kk] = *(const bf16x8*)(Z1 + (((size_t)(b * 4 + gq) * 128 + cp) * 128 + s2) * 128 + 32 * kk + 8 * g); }
#pragma unroll 1
        for (int nt = 0; nt < 4; ++nt) {
            bf16x8 bre[4], bim[4];
#pragma unroll
            for (int kk = 0; kk < 4; ++kk) { bre[kk] = *(const bf16x8*)(F1t + (16 * nt + qi) * 128 + 32 * kk + 8 * g); bim[kk] = *(const bf16x8*)(F1t + (64 + 16 * nt + qi) * 128 + 32 * kk + 8 * g); }
            const int s1p = 16 * nt + qi;
            bf16* tp = T2 + (((size_t)(b * 4 + gq) * 64 + s1p) * 128 + cp) * 256;
#pragma unroll
            for (int a = 0; a < 4; ++a) { f32x4 ar = (f32x4){0.f, 0.f, 0.f, 0.f}, ai = (f32x4){0.f, 0.f, 0.f, 0.f};
#pragma unroll
                for (int kk = 0; kk < 4; ++kk) { ar = MFMA16(af[a][kk], bre[kk], ar); ai = MFMA16(af[a][kk], bim[kk], ai); }
                const int s2b = 16 * (4 * hf + a) + 4 * g;
                const f32x4 t0 = *(const f32x4*)(TW + (size_t)(s1p * 128 + s2b) * 2), t1 = *(const f32x4*)(TW + (size_t)(s1p * 128 + s2b) * 2 + 4);
                const float c_[4] = {t0.x, t0.z, t1.x, t1.z}, s_[4] = {t0.y, t0.w, t1.y, t1.w};
                float re[4], im[4];
#pragma unroll
                for (int e = 0; e < 4; ++e) { re[e] = ar[e] * c_[e] + ai[e] * s_[e]; im[e] = ai[e] * c_[e] - ar[e] * s_[e]; }
                u32x2 w; w.x = pk2(re[0], re[1]); w.y = pk2(re[2], re[3]); *(u32x2*)(tp + s2b) = w;
                w.x = pk2(im[0], im[1]); w.y = pk2(im[2], im[3]); *(u32x2*)(tp + 128 + s2b) = w; }
        }
    }
}
__device__ __forceinline__ void four2_phase(LAS unsigned char* lds, const bf16* T2, const bf16* F2t, bf16* MG, const float* g_f, int G, int bid, int wave, int lane) {
    LAS float* ssq = (LAS float*)(lds + LDS_MISC);
    const int qi = lane & 15, g = lane >> 4, gq = wave >> 1, hf = wave & 1;
    for (int unit = bid; unit < 256; unit += G) {
        const int b = unit >> 6, s1p = unit & 63;
        f32x4 acc[4][8];
#pragma unroll
        for (int a = 0; a < 4; ++a)
#pragma unroll
            for (int nt = 0; nt < 8; ++nt) acc[a][nt] = (f32x4){0.f, 0.f, 0.f, 0.f};
#pragma unroll 1
        for (int kk = 0; kk < 8; ++kk) {
            bf16x8 af[4];
#pragma unroll
            for (int a = 0; a < 4; ++a) { const int cp = 16 * (4 * hf + a) + qi; af[a] = *(const bf16x8*)(T2 + (((size_t)(b * 4 + gq) * 64 + s1p) * 128 + cp) * 256 + 32 * kk + 8 * g); }
#pragma unroll
            for (int nt = 0; nt < 8; ++nt) { const bf16x8 bfr = *(const bf16x8*)(F2t + (16 * nt + qi) * 256 + 32 * kk + 8 * g);
#pragma unroll
                for (int a = 0; a < 4; ++a) acc[a][nt] = MFMA16(af[a], bfr, acc[a][nt]); }
        }
#pragma unroll
        for (int nt = 0; nt < 8; ++nt) { float part = 0.f;
#pragma unroll
            for (int a = 0; a < 4; ++a) part += (acc[a][nt].x * acc[a][nt].x + acc[a][nt].y * acc[a][nt].y) + (acc[a][nt].z * acc[a][nt].z + acc[a][nt].w * acc[a][nt].w);
            part += __shfl_xor(part, 16); part += __shfl_xor(part, 32);
            if (g == 0) ssq[wave * 128 + 16 * nt + qi] = part; }
        __syncthreads();
        float rstd[8];
#pragma unroll
        for (int nt = 0; nt < 8; ++nt) { float tot = 0.f;
#pragma unroll
            for (int w = 0; w < 8; ++w) tot += ssq[w * 128 + 16 * nt + qi];
            rstd[nt] = 1.0f / sqrtf(tot * (1.0f / 512.0f) + RMS_EPS); }
        __syncthreads();
#pragma unroll
        for (int a = 0; a < 4; ++a) { const int c4 = gq * 128 + 16 * (4 * hf + a) + 4 * g; const f32x4 gv = *(const f32x4*)(g_f + c4);
#pragma unroll
            for (int nt = 0; nt < 8; ++nt) { const size_t tok = (size_t)b * SEQ + s1p + 64 * (16 * nt + qi); const f32x4 v = acc[a][nt] * rstd[nt] * gv;
                u32x2 w; w.x = pk2(v.x, v.y); w.y = pk2(v.z, v.w); *(u32x2*)(MG + tok * DM + 512 + c4) = w; } }
    }
}

typedef __attribute__((address_space(1))) unsigned gu32;
constexpr size_t WS_CTL = 1 * MiB, CTL_ZERO_BYTES = 16384;
#define XB_TMO      128
#define XB_XCNT(j)  (256  + 64 * (j))
#define XB_XSUB(j)  (1280 + 64 * (j))
#define XB_XGEN(j)  (2304 + 64 * (j))
#define XB_TOP      3328
#define XB_TOPGEN   3392
#define XCD_BAR_WORDS 3456
#define XB_SPIN_CAP (1u << 18)

__device__ __forceinline__ unsigned xb_ld(unsigned* p)              { return __hip_atomic_load(p, __ATOMIC_RELAXED, __HIP_MEMORY_SCOPE_AGENT); }
__device__ __forceinline__ unsigned xb_add(unsigned* p, unsigned v) { return __hip_atomic_fetch_add(p, v, __ATOMIC_RELAXED, __HIP_MEMORY_SCOPE_AGENT); }
__device__ __forceinline__ unsigned xb_xcc_id() { return (unsigned)__builtin_amdgcn_s_getreg((3 << 11) | 20) & 0xFu; }
#define XB_SPIN(cond, bar) do { unsigned _sp = 0; while (cond) { __builtin_amdgcn_s_sleep(1); \
    if ((++_sp & 255u) == 0u) { if (xb_ld(&(bar)[XB_TMO])) break; if (_sp > XB_SPIN_CAP) { atomicAdd(&(bar)[XB_TMO], 1u); break; } } } } while (0)

struct XcdBarrier {
    unsigned* bar; unsigned x;
    volatile LAS unsigned* st;
};

__device__ __forceinline__ XcdBarrier xcd_barrier_post(unsigned* bar, volatile LAS unsigned* st) {
    XcdBarrier b; b.bar = bar; b.x = xb_xcc_id(); b.st = st;
    if (threadIdx.x == 0) (void)xb_add(&bar[XB_XCNT(b.x)], 1u);
    return b;
}
__device__ __forceinline__ void xcd_barrier_complete(unsigned* bar, unsigned x, unsigned& nloc, unsigned& nx) {
    const unsigned G = gridDim.x * gridDim.y * gridDim.z;
    unsigned sum, cnt, mine, sp = 0u;
    for (;;) {
        sum = 0u; cnt = 0u; mine = 0u;
#pragma unroll
        for (unsigned j = 0; j < 16; ++j) { const unsigned c = xb_ld(&bar[XB_XCNT(j)]); sum += c; cnt += (c > 0u) ? 1u : 0u; mine = (j == x) ? c : mine; }
        if (sum == G) break;
        __builtin_amdgcn_s_sleep(1);
        if ((++sp & 255u) == 0u) { if (xb_ld(&bar[XB_TMO])) break; if (sp > XB_SPIN_CAP) { atomicAdd(&bar[XB_TMO], 1u); break; } }
    }
    nloc = mine > 0u ? mine : 1u; nx = cnt > 0u ? cnt : 1u;
}

__device__ __forceinline__ void xcd_barrier(const XcdBarrier& b) {
    asm volatile("s_waitcnt vmcnt(0)" ::: "memory");
    __syncthreads();
    if (threadIdx.x == 0) {
        unsigned* bar = b.bar;
        __builtin_amdgcn_s_waitcnt(0);
        unsigned nloc = b.st[0], nx = b.st[1];
        if (nloc == 0u) { xcd_barrier_complete(bar, b.x, nloc, nx); b.st[0] = nloc; b.st[1] = nx; }
        const unsigned old = xb_add(&bar[XB_XSUB(b.x)], 1u);
        const unsigned gen = old / nloc;
        if (old + 1u == (gen + 1u) * nloc) {
            __builtin_amdgcn_fence(__ATOMIC_RELEASE, "agent");
            asm volatile("s_waitcnt vmcnt(0)" ::: "memory");
            const unsigned og = xb_add(&bar[XB_TOP], 1u);
            const unsigned tg = og / nx;
            if (og + 1u == (tg + 1u) * nx) xb_add(&bar[XB_TOPGEN], 1u);
            else XB_SPIN(xb_ld(&bar[XB_TOPGEN]) == tg, bar);
            __builtin_amdgcn_fence(__ATOMIC_ACQUIRE, "agent");
            xb_add(&bar[XB_XGEN(b.x)], 1u);
            asm volatile("s_waitcnt vmcnt(0)" ::: "memory");
        } else {
            XB_SPIN(xb_ld(&bar[XB_XGEN(b.x)]) == gen, bar);
            __builtin_amdgcn_fence(__ATOMIC_ACQUIRE, "agent");
            asm volatile("s_waitcnt vmcnt(0)" ::: "memory");
        }
    }
    __syncthreads();
}

struct Args { const float* in[18]; float* out; unsigned char* ws; int ph_lo, ph_hi, single, stop; };

typedef const __attribute__((address_space(4))) Args* KArgs;
__device__ __forceinline__ KArgs kargs() { KArgs p = (KArgs)__builtin_amdgcn_kernarg_segment_ptr(); asm volatile("" : "+s"(p)); return p; }
#define WSP(off) ((bf16*)(A->ws + (off)))

__global__ void __launch_bounds__(NWAVES * 64, 2) fwd_megakernel(Args a_unused) {
    extern __shared__ __attribute__((aligned(16))) unsigned char lds_raw[];
    LAS unsigned char* lds = (LAS unsigned char*)lds_raw;
    const int G = gridDim.x, bid = blockIdx.x;
    int ph = 0; int ph_lo, ph_hi, single, stop;
#if MK_PROF_A >= 0
    if (blockIdx.x == 0 && threadIdx.x == 0) { KArgs A_ = kargs(); ((unsigned long long*)(A_->ws + WS_CTL + 8192))[0] = __builtin_amdgcn_s_memrealtime(); }
#endif
    { KArgs A = kargs(); ph_lo = A->ph_lo; ph_hi = A->ph_hi; single = A->single; stop = A->stop; }
    volatile LAS unsigned* bst = (volatile LAS unsigned*)(lds + LDS_MISC + 8192);
    if (threadIdx.x < 2) bst[threadIdx.x] = 0u;
    __syncthreads();
    XcdBarrier bar; bar.bar = nullptr; bar.x = 0; bar.st = nullptr;
    if (single) { KArgs A = kargs(); bar = xcd_barrier_post((unsigned*)(A->ws + WS_CTL), bst);
        cg::this_grid().sync(); }
#define RUN (ph >= ph_lo && ph < ph_hi && ph < stop)
#if MK_PROF_A >= 0
#define SEAM() do { if (single) xcd_barrier(bar); if (bid == 0 && threadIdx.x == 0) { KArgs A_ = kargs(); ((unsigned long long*)(A_->ws + WS_CTL + 8192))[ph + 1] = __builtin_amdgcn_s_memrealtime(); } ++ph; } while (0)
#else
#define SEAM() do { if (single) xcd_barrier(bar); ++ph; } while (0)
#endif
#define IDS() int tid_ = threadIdx.x; asm volatile("" : "+v"(tid_)); const int tid = tid_, lane = tid & 63, wave = __builtin_amdgcn_readfirstlane(tid >> 6), gw = bid * NWAVES + wave, NGW = G * NWAVES; (void)lane; (void)gw; (void)NGW; (void)tid

    if (RUN) {
        KArgs A = kargs(); IDS();
        bf16* WB = WSP(WS_W); bf16* XB = WSP(WS_XB);
        bf16* F0t = WSP(WS_TAB + TAB_F0); bf16* F1t = WSP(WS_TAB + TAB_F1); bf16* F2t = WSP(WS_TAB + TAB_F2); float* TW = (float*)WSP(WS_TAB + TAB_TW);
        LAS float* scr = (LAS float*)(lds + wave * 16384);
        constexpr int I_G = 16 * 88, I_D = 44 * 32, I_IN = 16 * 64, I_OUT = 16 * 32, I_L = 4 * I_G + 2 * I_D + I_IN + I_OUT;
        for (int it = gw; it < NLAYER * I_L; it += NGW) {
            const int l = it / I_L; int r = it % I_L; bf16* wl = WB + (size_t)l * WL_END;
            if (r < I_G) { p0_transpose_item(A->in[1] + (size_t)l * DM * DFF, DM, DFF, wl + WL_GU1, 1, scr, r, lane); continue; } r -= I_G;
            if (r < I_G) { p0_transpose_item(A->in[2] + (size_t)l * DM * DFF, DM, DFF, wl + WL_GU1, 2, scr, r, lane); continue; } r -= I_G;
            if (r < I_D) { p0_transpose_item(A->in[3] + (size_t)l * DFF * DM, DFF, DM, wl + WL_D1, 0, scr, r, lane); continue; } r -= I_D;
            if (r < I_IN) { p0_transpose_item(A->in[6] + (size_t)l * DM * 2048, DM, 2048, wl + WL_IN, 0, scr, r, lane); continue; } r -= I_IN;
            if (r < I_OUT) { p0_transpose_item(A->in[10] + (size_t)l * DM * DM, DM, DM, wl + WL_OUT, 0, scr, r, lane); continue; } r -= I_OUT;
            if (r < I_G) { p0_transpose_item(A->in[13] + (size_t)l * DM * DFF, DM, DFF, wl + WL_GU2, 1, scr, r, lane); continue; } r -= I_G;
            if (r < I_G) { p0_transpose_item(A->in[14] + (size_t)l * DM * DFF, DM, DFF, wl + WL_GU2, 2, scr, r, lane); continue; } r -= I_G;
            p0_transpose_item(A->in[15] + (size_t)l * DFF * DM, DFF, DM, wl + WL_D2, 0, scr, r, lane);
        }
        const float* xin = A->in[0];
        for (int m = gw; m < MTOK; m += NGW) {
            const f32x4* xr = (const f32x4*)(xin + (size_t)m * DM) + lane; u32x2* ob = (u32x2*)(XB + (size_t)m * DM) + lane;
#pragma unroll
            for (int j = 0; j < 4; ++j) { const f32x4 v = xr[64 * j]; u32x2 w; w.x = pk2(v.x, v.y); w.y = pk2(v.z, v.w); ob[64 * j] = w; }
        }
        for (int i = bid * 512 + tid; i < 32768 + 16384 + 32768 + 8192; i += G * 512) {
            float sn, cs;
            if (i < 32768) { const int n = i >> 7, c = i & 127, ri = n >> 7, cp = n & 127; sincospif((float)((c * cp) & 127) * (1.0f / 64.0f), &sn, &cs); F0t[i] = (bf16)f2bf((ri == 0 ? cs : -sn) * 0.125f); }
            else if (i < 49152) { const int e = i - 32768, n = e >> 7, k = e & 127, rip = n >> 6, s1p = n & 63, ri = k >> 6, s1 = k & 63; sincospif((float)((s1 * s1p) & 63) * (1.0f / 32.0f), &sn, &cs);
                const float v = (rip == ri) ? cs : (rip == 0 ? sn : -sn); F1t[e] = (bf16)f2bf(v * 0.125f); }
            else if (i < 81920) { const int e = i - 49152, s2p = e >> 8, k = e & 255, ri = k >> 7, s2 = k & 127; sincospif((float)((s2 * s2p) & 127) * (1.0f / 64.0f), &sn, &cs); F2t[e] = (bf16)f2bf((ri == 0 ? cs : sn) * 0.0625f); }
            else { const int e = i - 81920, s1p = e >> 7, s2 = e & 127; sincospif((float)(s1p * s2) * (1.0f / 4096.0f), &sn, &cs); TW[2 * e] = cs; TW[2 * e + 1] = sn; }
        }
    }
    SEAM();

#pragma unroll 1
    for (int i = 0; i < 2 * NLAYER; ++i) {
        const int l = i >> 1, f = i & 1;
        if (f == 1) {
            if (RUN) { KArgs A = kargs(); pg8::Gemm gm{WSP(WS_XB), WSP(WS_W) + (size_t)l * WL_END + WL_IN, MTOK, 2048, DM}; pg8::StaticOrder S; S.init(MTOK, 2048, G, bid); EpiProj E{WSP(WS_Q)};
                pg8::gemm_phase<EpiProj, pg8::StaticOrder>(lds, gm, S, E, nullptr); }
            SEAM();
            if (RUN) { KArgs A = kargs(); IDS();
                _Pragma("unroll 1") for (int rep_ = 0; rep_ < MK_REP_ATTN; ++rep_) attn_phase(lds, WSP(WS_Q), WSP(WS_K), WSP(WS_VT), WSP(WS_MG), A->in[7] + (size_t)l * 8 * 465, A->in[8] + (size_t)l * 512, G, bid, wave, lane);
                _Pragma("unroll 1") for (int rep_ = 0; rep_ < MK_REP_F0; ++rep_) four0_phase(WSP(WS_U), WSP(WS_TAB + TAB_F0), WSP(WS_Z1), gw, NGW, lane); }
            SEAM();
            if (RUN) { KArgs A = kargs(); IDS(); _Pragma("unroll 1") for (int rep_ = 0; rep_ < MK_REP_F1; ++rep_) four1_phase(WSP(WS_Z1), WSP(WS_TAB + TAB_F1), (const float*)WSP(WS_TAB + TAB_TW), WSP(WS_T2), gw, NGW, lane); }
            SEAM();
            if (RUN) { KArgs A = kargs(); IDS(); _Pragma("unroll 1") for (int rep_ = 0; rep_ < MK_REP_F2; ++rep_) four2_phase(lds, WSP(WS_T2), WSP(WS_TAB + TAB_F2), WSP(WS_MG), A->in[9] + (size_t)l * 512, G, bid, wave, lane); }
            SEAM();
            if (RUN) { KArgs A = kargs(); pg8::Gemm gm{WSP(WS_MG), WSP(WS_W) + (size_t)l * WL_END + WL_OUT, MTOK, DM, DM}; pg8::StaticOrder S; S.init(MTOK, DM, G, bid); EpiResid E{A->out, A->out, 1.0f};
                pg8::gemm_phase<EpiResid, pg8::StaticOrder>(lds, gm, S, E, nullptr); }
            SEAM();
            if (RUN) { KArgs A = kargs(); IDS(); ln_rows(A->out, A->out, WSP(WS_XB), A->in[11] + (size_t)l * DM, A->in[12] + (size_t)l * DM, gw, NGW, lane); }
            SEAM();
        }
        if (RUN) { KArgs A = kargs(); pg8::Gemm gm{WSP(WS_XB), WSP(WS_W) + (size_t)l * WL_END + (f ? WL_GU2 : WL_GU1), MTOK, 2 * DFF, DM}; pg8::StaticOrder S; S.init(MTOK, 2 * DFF, G, bid); EpiSwiGLU E{WSP(WS_H)};
            pg8::gemm_phase<EpiSwiGLU, pg8::StaticOrder>(lds, gm, S, E, nullptr); }
        SEAM();
        if (RUN) { KArgs A = kargs(); pg8::Gemm gm{WSP(WS_H), WSP(WS_W) + (size_t)l * WL_END + (f ? WL_D2 : WL_D1), MTOK, DM, DFF}; pg8::StaticOrder S; S.init(MTOK, DM, G, bid);
            const float* src = A->out; if (i == 0) src = A->in[0];
            EpiResid E{src, A->out, 0.5f};
            pg8::gemm_phase<EpiResid, pg8::StaticOrder>(lds, gm, S, E, nullptr); }
        SEAM();
        if (RUN) { KArgs A = kargs(); IDS(); const float* gp = f ? A->in[16] : A->in[4]; const float* bp = f ? A->in[17] : A->in[5];
            ln_rows(A->out, A->out, WSP(WS_XB), gp + (size_t)l * DM, bp + (size_t)l * DM, gw, NGW, lane); }
        SEAM();
    }
#if MK_PROF_A >= 0
    if (bid == 0) { KArgs A = kargs(); const unsigned long long* ts = (const unsigned long long*)(A->ws + WS_CTL + 8192);
        const float dA = (float)(ts[MK_PROF_B + 1] - ts[MK_PROF_A]) * (0.01f / 200.0f);
        for (int i = threadIdx.x; i < (1 << 20); i += 512) A->out[i] = dA; }
#endif
#if MK_STOP < 25
    if (ph >= ph_lo && ph < ph_hi) {
        KArgs A = kargs(); const unsigned short* w16 = (const unsigned short*)A->ws; float* o = A->out;
        for (size_t i = (size_t)bid * 512 + threadIdx.x; i < (size_t)MTOK * DM; i += (size_t)G * 512) {
            float h = 0.f;
            for (int k = 0; k < 7; ++k) { const size_t j = i + (size_t)k * 33554432u; if (j < WS_END / 2) h += (float)w16[j]; }
            const unsigned b = __builtin_bit_cast(unsigned, o[i]);
            o[i] = h + (float)(b >> 16) + (float)(b & 0xffffu);
        }
    }
#endif
}
constexpr int N_PHASES = 1 + NLAYER * (3 + 6 + 3);

#ifndef MK_MULTI
#define MK_MULTI 0
#endif
extern "C" void kernel_launch(void* const* d_in, const int* in_sizes, int n_in, void* d_out, int out_size, void* d_ws, size_t ws_size, hipStream_t stream) {
    static int grid = 0;
    if (grid == 0) {
        if (n_in != 18 || out_size != MTOK * DM || ws_size < WS_END) { fprintf(stderr, "kernel_launch: unexpected shapes (n_in %d out %d ws %zu)\n", n_in, out_size, ws_size); grid = -1; return; }
        int dev = 0, cus = 0, per_cu = 0;
        (void)hipGetDevice(&dev); (void)hipDeviceGetAttribute(&cus, hipDeviceAttributeMultiprocessorCount, dev);
        if (hipFuncSetAttribute((const void*)fwd_megakernel, hipFuncAttributeMaxDynamicSharedMemorySize, LDS_BYTES) != hipSuccess) { fprintf(stderr, "kernel_launch: hipFuncSetAttribute failed\n"); grid = -1; return; }
        if (hipOccupancyMaxActiveBlocksPerMultiprocessor(&per_cu, (const void*)fwd_megakernel, NWAVES * 64, LDS_BYTES) != hipSuccess || per_cu < 1) { fprintf(stderr, "kernel_launch: occupancy query says %d\n", per_cu); per_cu = 1; }
        (void)hipGetLastError();
        grid = cus;
    }
    if (grid < 0) return;
    if (hipMemsetAsync((char*)d_ws + WS_CTL, 0, CTL_ZERO_BYTES, stream) != hipSuccess) { fprintf(stderr, "kernel_launch: memset failed\n"); return; }
    Args a{};
    for (int i = 0; i < 18; ++i) a.in[i] = (const float*)d_in[i];
    a.out = (float*)d_out; a.ws = (unsigned char*)d_ws;
#if MK_MULTI
    a.stop = MK_STOP;
    for (int p = 0; p < N_PHASES + (MK_STOP < 25 ? 1 : 0); ++p) { a.ph_lo = p; a.ph_hi = p + 1; a.single = 0; hipLaunchKernelGGL(fwd_megakernel, dim3(grid), dim3(NWAVES * 64), LDS_BYTES, stream, a); }
#else
    a.ph_lo = 0; a.ph_hi = N_PHASES + 1; a.single = 1; a.stop = MK_STOP;
    void* args[] = {&a};
    hipError_t e = hipLaunchCooperativeKernel((const void*)fwd_megakernel, dim3(grid), dim3(NWAVES * 64), args, LDS_BYTES, stream);
    if (e != hipSuccess) fprintf(stderr, "kernel_launch: cooperative launch failed: %s (grid %d)\n", hipGetErrorString(e), grid);
#endif
}
```
